# Optimizing an MI355X kernel written in HIP

```python
import functools
import jax, jax.numpy as jnp
from jax import lax
import numpy as np

D_MODEL = 1024
BATCH = 32
SEQ = 256
DEPTH = 4
DEC_BATCH = 4
DEC_SEQ = 4096
PAST_LEN = 512

GRID_W = 64
D_MIX = 1024
W_GRP = 256
HEAD_DIM = 64
N_HEADS_A = W_GRP // HEAD_DIM
WIN_H = 8
WIN_W = 16
CONV_W = 3
N_FOURIER = 4
N_HEADS_D = 4
DK = 64
DV = 64
GATE_RANK = 16
GLA_TAU = 16.0
CHUNK = 64
RMS_EPS = 1e-6
N_IN = 14 * W_GRP + 2 * GATE_RANK

kernel_name = 'hybrid_dit_na_conv_fnet_gla_step'


def rms_norm(x, g):
    xf = x.astype(jnp.float32)
    y = xf * lax.rsqrt(jnp.mean(xf * xf, axis=-1, keepdims=True) + RMS_EPS)
    return (y * g.astype(jnp.float32)).astype(x.dtype)


def to_heads(x, n):
    b, s, w = x.shape
    return x.reshape(b, s, n, w // n).transpose(0, 2, 1, 3)


def from_heads(x):
    b, n, s, d = x.shape
    return x.transpose(0, 2, 1, 3).reshape(b, s, n * d)


def adaln(cvec, w_mod_l, b_mod_l):
    m = jax.nn.silu(cvec) @ w_mod_l + b_mod_l
    shift, scale, gate = jnp.split(m, 3, axis=-1)
    return shift, scale, gate


def split_in(p):
    sizes = [W_GRP] * 14 + [GATE_RANK, GATE_RANK]
    idx = [int(i) for i in np.cumsum(sizes)[:-1]]
    return jnp.split(p, idx, axis=-1)


def attn_ctx(q, k, v):
    s = jnp.einsum('bhqd,bhkd->bhqk', q, k).astype(jnp.float32)
    p = jax.nn.softmax(s, axis=-1).astype(v.dtype)
    return jnp.einsum('bhqk,bhkd->bhqd', p, v)


def neighbourhood_attn(q, k, v, ck, cv, rpb_l):
    b, h, n, d = q.shape
    rows = n // GRID_W
    kh = min(WIN_H, rows)
    r = np.arange(rows)
    rs = np.clip(r - kh // 2, 0, rows - kh)
    row_idx = rs[:, None] + np.arange(kh)[None, :]
    dr = row_idx - r[:, None] + (WIN_H - 1)
    col = np.arange(GRID_W)
    cs = np.clip(col - WIN_W // 2, 0, GRID_W - WIN_W)
    col_ok = (col[None, :] >= cs[:, None]) & (col[None, :] < cs[:, None] + WIN_W)
    dc = np.clip(col[None, :] - col[:, None] + (WIN_W - 1), 0, 2 * WIN_W - 2)
    qg = q.reshape(b, h, rows, GRID_W, d)
    kg = k.reshape(b, h, rows, GRID_W, d)[:, :, row_idx]
    vg = v.reshape(b, h, rows, GRID_W, d)[:, :, row_idx]
    s_lat = jnp.einsum('bhrqd,bhrikd->bhrqik', qg, kg).astype(jnp.float32)
    bias = rpb_l[:, dr[:, None, :, None], dc[None, :, None, :]]
    s_lat = jnp.where(col_ok[:, None, :], s_lat + bias.astype(jnp.float32), -jnp.inf)
    s_ctx = jnp.einsum('bhrqd,bhcd->bhrqc', qg, ck).astype(jnp.float32)
    n_lat = kh * GRID_W
    s_all = jnp.concatenate([s_lat.reshape(b, h, rows, GRID_W, n_lat), s_ctx], axis=-1)
    p = jax.nn.softmax(s_all, axis=-1).astype(v.dtype)
    p_lat = p[..., :n_lat].reshape(b, h, rows, GRID_W, kh, GRID_W)
    o = (jnp.einsum('bhrqik,bhrikd->bhrqd', p_lat, vg)
         + jnp.einsum('bhrqc,bhcd->bhrqd', p[..., n_lat:], cv))
    return o.reshape(b, h, n, d)


def short_conv(bB, cB, hB, w):
    u = cB * hB
    up = jnp.pad(u, ((0, 0), (1, 1), (0, 0)))
    y = up[:, :-2] * w[0] + up[:, 1:-1] * w[1] + up[:, 2:] * w[2]
    return bB * y


def fourier_mix(u):
    b, s, w = u.shape
    ug = u.reshape(b, s, N_FOURIER, w // N_FOURIER).astype(jnp.float32)
    f = jnp.fft.fftn(ug, axes=(1, 3), norm='ortho').real
    return f.reshape(b, s, w).astype(u.dtype)


def gla_dir(q, k, v, log_a, s0):
    b, h, s, _ = q.shape
    nc = s // CHUNK
    rc = lambda t: t.reshape(b, h, nc, CHUNK, t.shape[-1])
    qc, kc, vc, gc = rc(q), rc(k), rc(v), rc(log_a)
    cum = jnp.cumsum(gc, axis=3)
    total = cum[:, :, :, -1:]
    q_dec = qc * jnp.exp(cum)
    k_inv = kc * jnp.exp(-cum)
    k_end = kc * jnp.exp(total - cum)
    causal = np.tril(np.ones((CHUNK, CHUNK), dtype=bool))
    att = jnp.where(causal, jnp.einsum('bhntk,bhnsk->bhnts', q_dec, k_inv), 0.0)
    o_intra = jnp.einsum('bhnts,bhnsv->bhntv', att, vc)
    upd = jnp.einsum('bhnsk,bhnsv->bhnkv', k_end, vc)
    decay = jnp.exp(total[:, :, :, 0])

    def step(state, inp):
        d_c, u_c = inp
        return d_c[..., None] * state + u_c, state

    s_fin, s_start = lax.scan(step, s0.astype(jnp.float32),
                              (jnp.moveaxis(decay, 2, 0), jnp.moveaxis(upd, 2, 0)))
    s_start = jnp.moveaxis(s_start, 0, 2)
    o_inter = jnp.einsum('bhntk,bhnkv->bhntv', q_dec, s_start)
    return (o_intra + o_inter).reshape(b, h, s, DV), s_fin


def gla_mixer(qD, kD, vD, aF, aB, up_f, b_f, up_b, b_b, s0_f, s0_b, gn):
    f32 = jnp.float32
    q = to_heads(qD, N_HEADS_D).astype(f32) * (DK ** -0.5)
    k = to_heads(kD, N_HEADS_D).astype(f32)
    v = to_heads(vD, N_HEADS_D).astype(f32)
    la_f = to_heads(jax.nn.log_sigmoid((aF @ up_f + b_f).astype(f32)) / GLA_TAU, N_HEADS_D)
    la_b = to_heads(jax.nn.log_sigmoid((aB @ up_b + b_b).astype(f32)) / GLA_TAU, N_HEADS_D)
    flip = lambda t: jnp.flip(t, axis=2)
    o_f, s_f = gla_dir(q, k, v, la_f, s0_f)
    o_b, s_b = gla_dir(flip(q), flip(k), flip(v), flip(la_b), s0_b)
    o = rms_norm(o_f + flip(o_b), gn)
    return from_heads(o).astype(qD.dtype), s_f, s_b


def trunk_layer(x, shift, scale, gate, attn_fn, s0_f, s0_b,
                norm_g_l, w_in_l, qn_l, kn_l, conv_l, up_f, b_f, up_b, b_b, gn_l, w_out_l):
    hN = rms_norm(x, norm_g_l) * (1.0 + scale) + shift
    p = hN @ w_in_l
    (qA, kA, vA, gA, bB, cB, hB, gB, uC, gC, qD, kD, vD, gD, aF, aB) = split_in(p)
    q = rms_norm(to_heads(qA, N_HEADS_A), qn_l) * (HEAD_DIM ** -0.5)
    k = rms_norm(to_heads(kA, N_HEADS_A), kn_l)
    v = to_heads(vA, N_HEADS_A)
    yA = from_heads(attn_fn(q, k, v)) * jax.nn.silu(gA)
    yB = short_conv(bB, cB, hB, conv_l) * jax.nn.silu(gB)
    yC = fourier_mix(uC) * jax.nn.silu(gC)
    oD, s_f, s_b = gla_mixer(qD, kD, vD, aF, aB, up_f, b_f, up_b, b_b, s0_f, s0_b, gn_l)
    yD = oD * jax.nn.silu(gD)
    y = jnp.concatenate([yA, yB, yC, yD], axis=-1) @ w_out_l
    return x + gate * y, k, v, s_f, s_b


def setup_inputs(seed: int = 0) -> dict:
    key = jax.random.key(seed)
    ks = jax.random.split(key, 24)
    nrm = lambda kk, shape, s: jax.random.normal(kk, shape, jnp.float32) * s
    return {
        'x_prompt': nrm(ks[0], (BATCH, SEQ, D_MODEL), 1.0),
        'x_sample': nrm(ks[1], (DEC_BATCH, DEC_SEQ, D_MODEL), 1.0),
        'cache_k': nrm(ks[2], (DEC_BATCH, DEPTH, N_HEADS_A, PAST_LEN, HEAD_DIM), 1.0),
        'cache_v': nrm(ks[3], (DEC_BATCH, DEPTH, N_HEADS_A, PAST_LEN, HEAD_DIM), 1.0),
        'state_gla': nrm(ks[4], (DEC_BATCH, DEPTH, 2, N_HEADS_D, DK, DV), 0.5),
        'c': nrm(ks[5], (DEC_BATCH, D_MODEL), 1.0),
        'c_ctx': nrm(ks[6], (D_MODEL,), 1.0),
        'norm_g': 1.0 + nrm(ks[7], (DEPTH, D_MODEL), 0.02),
        'w_mod': nrm(ks[8], (DEPTH, D_MODEL, 3 * D_MODEL), 0.5 * D_MODEL ** -0.5),
        'b_mod': nrm(ks[9], (DEPTH, 3 * D_MODEL), 0.02),
        'w_in': nrm(ks[10], (DEPTH, D_MODEL, N_IN), D_MODEL ** -0.5),
        'q_norm_g': 1.0 + nrm(ks[11], (DEPTH, HEAD_DIM), 0.02),
        'k_norm_g': 1.0 + nrm(ks[12], (DEPTH, HEAD_DIM), 0.02),
        'rpb': nrm(ks[13], (DEPTH, N_HEADS_A, 2 * WIN_H - 1, 2 * WIN_W - 1), 0.1),
        'conv_w': nrm(ks[14], (DEPTH, CONV_W, W_GRP), CONV_W ** -0.5),
        'gla_up_f': nrm(ks[15], (DEPTH, GATE_RANK, W_GRP), GATE_RANK ** -0.5),
        'gla_bias_f': nrm(ks[16], (DEPTH, W_GRP), 0.1),
        'gla_up_b': nrm(ks[17], (DEPTH, GATE_RANK, W_GRP), GATE_RANK ** -0.5),
        'gla_bias_b': nrm(ks[18], (DEPTH, W_GRP), 0.1),
        'gla_norm_g': 1.0 + nrm(ks[19], (DEPTH, DV), 0.02),
        'w_out': nrm(ks[20], (DEPTH, D_MIX, D_MODEL), D_MIX ** -0.5),
    }


def reference(x_prompt, x_sample, cache_k, cache_v, state_gla, c, c_ctx, norm_g, w_mod, b_mod,
              w_in, q_norm_g, k_norm_g, rpb, conv_w, gla_up_f, gla_bias_f, gla_up_b, gla_bias_b,
              gla_norm_g, w_out):
    def layer_params(l):
        return (norm_g[l], w_in[l], q_norm_g[l], k_norm_g[l], conv_w[l], gla_up_f[l],
                gla_bias_f[l], gla_up_b[l], gla_bias_b[l], gla_norm_g[l], w_out[l])

    x = x_prompt
    zero_state = jnp.zeros((x_prompt.shape[0], N_HEADS_D, DK, DV), jnp.float32)
    ks_, vs_, ss_ = [], [], []
    for l in range(DEPTH):
        shift, scale, gate = adaln(c_ctx, w_mod[l], b_mod[l])
        x, k, v, s_f, s_b = trunk_layer(x, shift, scale, gate, attn_ctx, zero_state, zero_state,
                                        *layer_params(l))
        ks_.append(k)
        vs_.append(v)
        ss_.append(jnp.stack([s_f, s_b], axis=1))
    y_prompt = x
    new_cache_k = jnp.stack(ks_, axis=1)
    new_cache_v = jnp.stack(vs_, axis=1)
    new_state_gla = jnp.stack(ss_, axis=1)

    xs = x_sample
    for l in range(DEPTH):
        shift, scale, gate = adaln(c, w_mod[l], b_mod[l])
        attn_fn = functools.partial(neighbourhood_attn, ck=cache_k[:, l], cv=cache_v[:, l],
                                    rpb_l=rpb[l])
        xs, _, _, _, _ = trunk_layer(xs, shift[:, None, :], scale[:, None, :], gate[:, None, :],
                                     attn_fn, state_gla[:, l, 0], state_gla[:, l, 1],
                                     *layer_params(l))
    y_sample = xs
    return (y_prompt, y_sample, new_cache_k, new_cache_v, new_state_gla)
```

```cpp
#ifndef PROBE
#define PROBE 0
#endif
#include <hip/hip_runtime.h>
#include <hip/hip_cooperative_groups.h>
#include <cstdio>
#include <cstdint>
namespace cg = cooperative_groups;

#define LAS __attribute__((address_space(3)))
typedef unsigned short bf16_t;
typedef short bf16x8 __attribute__((ext_vector_type(8)));
typedef short bf16x4 __attribute__((ext_vector_type(4)));
typedef float f32x4 __attribute__((ext_vector_type(4)));
typedef float f32x16 __attribute__((ext_vector_type(16)));
typedef unsigned u32x4 __attribute__((ext_vector_type(4)));
typedef unsigned u32x2 __attribute__((ext_vector_type(2)));

constexpr int DM = 1024, NCTXR = 8192, NDENR = 16384, MROWS = 24576, NPW = 3584, NIN = 3616;
constexpr int NTHREADS = 512;
constexpr int LDS_BYTES = 147456;
constexpr int PQ = 0, PBB = 256, PUC = 512, PVD = 768, PKA = 1024, PVA = 1280, PGA = 1536, PCB = 1792, PHB = 2048, PGB = 2304, PGC = 2560, PQD = 2816, PKD = 3072, PGD = 3328;
constexpr long long OFF_YP = 0, OFF_CK = 25165824LL, OFF_CV = 33554432LL, OFF_ST = 41943040LL;
constexpr size_t WS_P = 0;
constexpr size_t WS_R = WS_P + (size_t)MROWS * NPW * 2;
constexpr size_t WS_WIN = WS_R + (size_t)MROWS * DM * 2;
constexpr size_t WS_WA = WS_WIN + (size_t)2 * NPW * DM * 2;
constexpr size_t WS_WOUT = WS_WA + (size_t)2 * 32 * DM * 2;
constexpr size_t WS_MOD = WS_WOUT + (size_t)2 * DM * DM * 2;
constexpr size_t WS_AFB = WS_MOD + (size_t)4 * 5 * 3072 * 4;
constexpr size_t WS_DEC = WS_AFB + (size_t)MROWS * 32 * 4;
constexpr size_t WS_CKB = WS_DEC + (size_t)3072 * 64 * 4;
constexpr size_t WS_CVB = WS_CKB + (size_t)2097152 * 2;
constexpr size_t WS_BAR = WS_CVB + (size_t)2097152 * 2;
constexpr size_t WS_END = WS_BAR + (size_t)16384;
constexpr size_t R_ZI = 12582912, R_ST = 25165824;

struct Params {
  const float* in[21];
  float* out;
  unsigned char* ws;
};
enum { I_XP = 0, I_XS, I_CK, I_CV, I_SG, I_C, I_CCTX, I_NG, I_WMOD, I_BMOD, I_WIN, I_QG, I_KG, I_RPB, I_CONV, I_UPF, I_BF, I_UPB, I_BB, I_GN, I_WOUT };

typedef __bf16 bf16v2_t __attribute__((ext_vector_type(2)));
typedef float f32v2_t __attribute__((ext_vector_type(2)));
__device__ __forceinline__ unsigned cvt_pk_bf16(float lo, float hi) { f32v2_t v = {lo, hi}; bf16v2_t b = __builtin_convertvector(v, bf16v2_t); return __builtin_bit_cast(unsigned, b); }
__device__ __forceinline__ float bf2f(unsigned short h) { return __uint_as_float(((unsigned)h) << 16); }
__device__ __forceinline__ float bflo(unsigned w) { return __uint_as_float(w << 16); }
__device__ __forceinline__ float bfhi(unsigned w) { return __uint_as_float(w & 0xffff0000u); }
__device__ __forceinline__ unsigned short f2bf(float f) { return (unsigned short)(cvt_pk_bf16(f, 0.f) & 0xffffu); }
__device__ __forceinline__ float siluf(float x) { return x / (1.f + __expf(-x)); }
__device__ __forceinline__ float logsigf(float z) { return fminf(z, 0.f) - __logf(1.f + __expf(-fabsf(z))); }
__device__ __forceinline__ bf16x8 as_bf16x8(u32x4 v) { return __builtin_bit_cast(bf16x8, v); }
__device__ __forceinline__ f32x16 mfma32(bf16x8 a, bf16x8 b, f32x16 c) { return __builtin_amdgcn_mfma_f32_32x32x16_bf16(a, b, c, 0, 0, 0); }
__device__ __forceinline__ f32x16 zero16() { f32x16 z;
#pragma unroll
  for (int i = 0; i < 16; ++i) z[i] = 0.f; return z; }
__device__ __forceinline__ bf16x8 pack8(const f32x16& a, int s) {
  u32x4 w; w.x = cvt_pk_bf16(a[8 * s + 0], a[8 * s + 1]); w.y = cvt_pk_bf16(a[8 * s + 2], a[8 * s + 3]); w.z = cvt_pk_bf16(a[8 * s + 4], a[8 * s + 5]); w.w = cvt_pk_bf16(a[8 * s + 6], a[8 * s + 7]);
  return as_bf16x8(w);
}
__device__ __forceinline__ bf16x8 ld_frag16(const void* p) { return as_bf16x8(*(const u32x4*)p); }
__device__ __forceinline__ bf16x8 ld_frag8x2(const void* lo, const void* hi) { u32x2 a = *(const u32x2*)lo, b = *(const u32x2*)hi; u32x4 w; w.x = a.x; w.y = a.y; w.z = b.x; w.w = b.y; return as_bf16x8(w); }
__device__ __forceinline__ bf16x8 ld_f32x8_as_bf16(const float* p) { f32x4 a = *(const f32x4*)p, b = *(const f32x4*)(p + 4); u32x4 w; w.x = cvt_pk_bf16(a[0], a[1]); w.y = cvt_pk_bf16(a[2], a[3]); w.z = cvt_pk_bf16(b[0], b[1]); w.w = cvt_pk_bf16(b[2], b[3]); return as_bf16x8(w); }

__device__ __forceinline__ int row_vec(int row) { return row < NCTXR ? 0 : 1 + ((row - NCTXR) >> 12); }

__device__ __forceinline__ int otid() { int t = threadIdx.x; asm volatile("" : "+v"(t)); return t; }
__device__ __forceinline__ int obid() { int t = blockIdx.x; asm volatile("" : "+s"(t)); return t; }
__device__ __forceinline__ int ogdim() { int t = gridDim.x; asm volatile("" : "+s"(t)); return t; }


#define XB_TMO      128
#define XB_XCNT(j)  (256  + 64 * (j))
#define XB_XSUB(j)  (1280 + 64 * (j))
#define XB_XGEN(j)  (2304 + 64 * (j))
#define XB_TOP      3328
#define XB_TOPGEN   3392
#define XCD_BAR_WORDS 3456
#define XB_SPIN_CAP (1u << 18)
__device__ __forceinline__ unsigned xb_ld(unsigned* p)              { return __hip_atomic_load(p, __ATOMIC_RELAXED, __HIP_MEMORY_SCOPE_AGENT); }
__device__ __forceinline__ unsigned xb_add(unsigned* p, unsigned v) { return __hip_atomic_fetch_add(p, v, __ATOMIC_RELAXED, __HIP_MEMORY_SCOPE_AGENT); }
__device__ __forceinline__ unsigned xb_xcc_id() { return (unsigned)__builtin_amdgcn_s_getreg((3 << 11) | 20) & 0xFu; }
#define XB_SPIN(cond, bar) do { unsigned _sp = 0; while (cond) { __builtin_amdgcn_s_sleep(1); \
    if ((++_sp & 255u) == 0u) { if (xb_ld(&(bar)[XB_TMO])) break; if (_sp > XB_SPIN_CAP) { atomicAdd(&(bar)[XB_TMO], 1u); break; } } } } while (0)
struct XcdBarrier { unsigned* bar; unsigned x; volatile LAS unsigned* st; };
__device__ __forceinline__ XcdBarrier xcd_barrier_post(unsigned* bar, volatile LAS unsigned* st) {
  XcdBarrier b; b.bar = bar; b.x = xb_xcc_id(); b.st = st;
  if (threadIdx.x == 0) (void)xb_add(&bar[XB_XCNT(b.x)], 1u);
  return b;
}
__device__ __forceinline__ void xcd_barrier_complete(unsigned* bar, unsigned x, unsigned& nloc, unsigned& nx) {
  const unsigned G = gridDim.x * gridDim.y * gridDim.z;
  unsigned sum, cnt, mine, sp = 0u;
  for (;;) {
    sum = 0u; cnt = 0u; mine = 0u;
#pragma unroll
    for (unsigned j = 0; j < 16; ++j) { const unsigned c = xb_ld(&bar[XB_XCNT(j)]); sum += c; cnt += (c > 0u) ? 1u : 0u; mine = (j == x) ? c : mine; }
    if (sum == G) break;
    __builtin_amdgcn_s_sleep(1);
    if ((++sp & 255u) == 0u) { if (xb_ld(&bar[XB_TMO])) break; if (sp > XB_SPIN_CAP) { atomicAdd(&bar[XB_TMO], 1u); break; } }
  }
  nloc = mine > 0u ? mine : 1u; nx = cnt > 0u ? cnt : 1u;
}
__device__ __forceinline__ void xcd_barrier(const XcdBarrier& b) {
  asm volatile("s_waitcnt vmcnt(0)" ::: "memory");
  __syncthreads();
  if (threadIdx.x == 0) {
    unsigned* bar = b.bar;
    __builtin_amdgcn_s_waitcnt(0);
    unsigned nloc = b.st[0], nx = b.st[1];
    if (nloc == 0u) { xcd_barrier_complete(bar, b.x, nloc, nx); b.st[0] = nloc; b.st[1] = nx; }
    const unsigned old = xb_add(&bar[XB_XSUB(b.x)], 1u);
    const unsigned gen = old / nloc;
    if (old + 1u == (gen + 1u) * nloc) {
      __builtin_amdgcn_fence(__ATOMIC_RELEASE, "agent");
      asm volatile("s_waitcnt vmcnt(0)" ::: "memory");
      const unsigned og = xb_add(&bar[XB_TOP], 1u);
      const unsigned tg = og / nx;
      if (og + 1u == (tg + 1u) * nx) xb_add(&bar[XB_TOPGEN], 1u);
      else XB_SPIN(xb_ld(&bar[XB_TOPGEN]) == tg, bar);
      __builtin_amdgcn_fence(__ATOMIC_ACQUIRE, "agent");
      xb_add(&bar[XB_XGEN(b.x)], 1u);
      asm volatile("s_waitcnt vmcnt(0)" ::: "memory");
    } else {
      XB_SPIN(xb_ld(&bar[XB_XGEN(b.x)]) == gen, bar);
      __builtin_amdgcn_fence(__ATOMIC_ACQUIRE, "agent");
      asm volatile("s_waitcnt vmcnt(0)" ::: "memory");
    }
  }
  __syncthreads();
}

namespace pg8 {
constexpr int BM = 256, BK = 64, HALF = 128, HTB = HALF * BK * 2, NXCD = 8, WGM = 8;
__host__ __device__ __forceinline__ int lds_byte(int r, int c) { const int st = (r >> 4) * 2 + (c >> 5), rr = r & 15, cc = c & 31, ob = rr * 64 + cc * 2; return st * 1024 + (ob ^ (((ob >> 9) & 1) << 5)); }
__host__ __device__ __forceinline__ void stage_rc(int b, int& R, int& C) { const int st = b / 1024, sb = b % 1024, swz = sb ^ (((sb >> 9) & 1) << 5); R = (st >> 1) * 16 + swz / 64; C = (st & 1) * 32 + (swz % 64) / 2; }
struct Unit { int pm, pn; };
struct Gemm { const bf16_t* A; const bf16_t* Bt; int M, N, K, lda; };
struct StaticOrder {
  int nM, nN, nwg, G, c;
  __device__ void init(int M, int N, int G_, int c_) { nM = M / BM; nN = N / BM; nwg = nM * nN; G = G_; c = c_; }
  __device__ bool next(int i, Unit& u) const {
    const long L = (long)i * G + c; if (L >= nwg) return false;
    int wgid = (int)L; { const int q = nwg / NXCD, r = nwg % NXCD, xcd = wgid % NXCD, off = wgid / NXCD; wgid = (xcd < r ? xcd * (q + 1) : r * (q + 1) + (xcd - r) * q) + off; }
    const int nig = WGM * nN, gid = wgid / nig, fm = gid * WGM, gsz = (nM - fm) < WGM ? (nM - fm) : WGM;
    u.pm = fm + ((wgid % nig) % gsz); u.pn = (wgid % nig) / gsz; return true;
  }
};
template <class Epi>
__device__ __forceinline__ void gemm_phase(LAS unsigned char* lds, const Gemm g, const StaticOrder& S, const Epi& E) {
  const int tidx_ = otid(), bidx_ = obid(), gdim_ = ogdim(); (void)tidx_; (void)bidx_; (void)gdim_;
  const int tid = tidx_, wid = __builtin_amdgcn_readfirstlane(tid >> 6), lane = tid & 63, wr = wid >> 2, wc = wid & 3, fr = lane & 15, fq = lane >> 4;
  const int K = g.K, nt = K / BK, lda = g.lda;
  unsigned voffA[2], voffB[2];
#pragma unroll
  for (int i = 0; i < 2; ++i) { int R, C; stage_rc(tid * 16 + i * 8192, R, C); voffA[i] = (unsigned)(R * lda + C) * 2u; voffB[i] = (unsigned)(R * K + C) * 2u; }
  const size_t kstep = (size_t)(BK * 2);
  const size_t hstepA = (size_t)HALF * lda * 2, hstepB = (size_t)HALF * K * 2;
  const size_t tstepA = 2 * hstepA, tstepB = 2 * hstepB;
  const unsigned ldsw = (unsigned)wid * 1024u;
  const int aoff = lds_byte(wr * 64 + fr, fq * 8), boff = lds_byte(wc * 32 + fr, fq * 8);
#define PG8_SA(b, h) (((b) * 2 + (h)) * HTB)
#define PG8_SB(b, h) ((4 + (b) * 2 + (h)) * HTB)
#define PG8_STAGE(bufoff, gbase, voff) do { _Pragma("unroll") for (int _i = 0; _i < 2; ++_i) \
    __builtin_amdgcn_global_load_lds((const unsigned*)((const char*)(gbase) + (voff)[_i]), (LAS unsigned*)(lds + (bufoff) + ldsw + _i * 8192), 16, 0, 0); } while (0)
#define PG8_LDA(dst, b, h) do { _Pragma("unroll") for (int m = 0; m < 4; ++m) _Pragma("unroll") for (int k = 0; k < 2; ++k) dst[m][k] = *(const LAS bf16x8*)(lds + PG8_SA(b, h) + aoff + m * 2048 + k * 1024); } while (0)
#define PG8_LDB(dst, b, h) do { _Pragma("unroll") for (int n = 0; n < 2; ++n) _Pragma("unroll") for (int k = 0; k < 2; ++k) dst[n][k] = *(const LAS bf16x8*)(lds + PG8_SB(b, h) + boff + n * 2048 + k * 1024); } while (0)
#define PG8_MMA(ai, bj, At, Bt) do { __builtin_amdgcn_s_setprio(1); _Pragma("unroll") for (int m = 0; m < 4; ++m) _Pragma("unroll") for (int n = 0; n < 2; ++n) _Pragma("unroll") for (int k = 0; k < 2; ++k) \
    acc[ai][bj][m][n] = __builtin_amdgcn_mfma_f32_16x16x32_bf16(Bt[n][k], At[m][k], acc[ai][bj][m][n], 0, 0, 0); __builtin_amdgcn_s_setprio(0); } while (0)
#define PG8_WAIT_V(n) asm volatile("s_waitcnt vmcnt(" #n ")" ::: "memory")
#define PG8_WAIT_L(n) asm volatile("s_waitcnt lgkmcnt(" #n ")" ::: "memory")
#define PG8_BAR __builtin_amdgcn_s_barrier()
#define PG8_SCHED __builtin_amdgcn_sched_barrier(0)
  Unit cur, nxt; int ui = 0;
  if (!S.next(0, cur)) return;
  f32x4 acc[2][2][4][2];
#pragma unroll
  for (int a = 0; a < 2; ++a)
#pragma unroll
    for (int b = 0; b < 2; ++b)
#pragma unroll
      for (int m = 0; m < 4; ++m)
#pragma unroll
        for (int n = 0; n < 2; ++n) acc[a][b][m][n] = (f32x4){0.f, 0.f, 0.f, 0.f};
  bf16x8 At[4][2], B0[2][2], B1[2][2];
  const char* cA = (const char*)g.A + (size_t)cur.pm * tstepA; const char* cB = (const char*)g.Bt + (size_t)cur.pn * tstepB;
  PG8_STAGE(PG8_SB(0, 0), cB, voffB); PG8_STAGE(PG8_SB(0, 1), cB + hstepB, voffB); PG8_STAGE(PG8_SA(0, 0), cA, voffA); PG8_STAGE(PG8_SA(0, 1), cA + hstepA, voffA);
  if (wr == 1) PG8_BAR;
  PG8_WAIT_V(2); PG8_BAR;
  PG8_STAGE(PG8_SB(1, 0), cB + kstep, voffB); PG8_STAGE(PG8_SA(1, 0), cA + kstep, voffA); PG8_STAGE(PG8_SB(1, 1), cB + hstepB + kstep, voffB);
  PG8_WAIT_V(6); PG8_BAR;
  for (;;) {
    const bool has_next = S.next(ui + 1, nxt);
    const char* nA = has_next ? (const char*)g.A + (size_t)nxt.pm * tstepA : cA; const char* nB = has_next ? (const char*)g.Bt + (size_t)nxt.pn * tstepB : cB;
    for (int t = 0; t < nt; t += 2) {
      const bool last = (t == nt - 2);
      const char* a1 = cA + (size_t)(t + 1) * kstep;
      const char* a2 = last ? nA : cA + (size_t)(t + 2) * kstep; const char* b2 = last ? nB : cB + (size_t)(t + 2) * kstep;
      const char* a3 = a2 + kstep; const char* b3 = b2 + kstep;
      PG8_LDB(B0, 0, 0); PG8_LDB(B1, 0, 1); PG8_SCHED; PG8_LDA(At, 0, 0); PG8_STAGE(PG8_SA(1, 1), a1 + hstepA, voffA);
      PG8_WAIT_V(8); PG8_WAIT_L(0); PG8_BAR; PG8_MMA(0, 0, At, B0); PG8_MMA(0, 1, At, B1); PG8_BAR; PG8_SCHED;
      PG8_LDA(At, 0, 1); PG8_STAGE(PG8_SB(0, 0), b2, voffB); PG8_STAGE(PG8_SB(0, 1), b2 + hstepB, voffB); PG8_STAGE(PG8_SA(0, 0), a2, voffA);
      PG8_WAIT_V(8); PG8_WAIT_L(0); PG8_BAR; PG8_MMA(1, 0, At, B0); PG8_MMA(1, 1, At, B1); PG8_BAR; PG8_SCHED;
      PG8_LDB(B0, 1, 0); PG8_LDB(B1, 1, 1); PG8_SCHED; PG8_LDA(At, 1, 0); PG8_STAGE(PG8_SA(0, 1), a2 + hstepA, voffA);
      PG8_WAIT_V(8); PG8_WAIT_L(0); PG8_BAR; PG8_MMA(0, 0, At, B0); PG8_MMA(0, 1, At, B1); PG8_BAR; PG8_SCHED;
      PG8_LDA(At, 1, 1); PG8_STAGE(PG8_SB(1, 0), b3, voffB); PG8_STAGE(PG8_SB(1, 1), b3 + hstepB, voffB); PG8_STAGE(PG8_SA(1, 0), a3, voffA);
      PG8_WAIT_V(8); PG8_WAIT_L(0); PG8_BAR; PG8_MMA(1, 0, At, B0); PG8_MMA(1, 1, At, B1); PG8_BAR; PG8_SCHED;
    }
    if (wr == 0) PG8_BAR;
    E(acc, cur, wr, wc, fr, fq);
    if (!has_next) break;
#pragma unroll
    for (int a = 0; a < 2; ++a)
#pragma unroll
      for (int b = 0; b < 2; ++b)
#pragma unroll
        for (int m = 0; m < 4; ++m)
#pragma unroll
          for (int n = 0; n < 2; ++n) acc[a][b][m][n] = (f32x4){0.f, 0.f, 0.f, 0.f};
    cur = nxt; cA = nA; cB = nB; ++ui;
    if (wr == 1) PG8_BAR;
  }
  PG8_WAIT_V(0);
  PG8_BAR;
#undef PG8_SA
#undef PG8_SB
#undef PG8_STAGE
#undef PG8_LDA
#undef PG8_LDB
#undef PG8_MMA
#undef PG8_WAIT_V
#undef PG8_WAIT_L
#undef PG8_BAR
#undef PG8_SCHED
}
}

struct EpiIn {
  bf16_t* P; const float* qg; const float* kg; float* ck; float* cv; int layer;
  __device__ __forceinline__ void operator()(const f32x4 (&acc)[2][2][4][2], const pg8::Unit& u, int wr, int wc, int fr, int fq) const {
    const int gp = u.pn;
    const int row0 = u.pm * 256 + wr * 64 + fr;
    const int cl = wc * 64 + 8 * fq;
    const bool isq = (gp == 0), isk = (gp == 4), isv = (gp == 5), isqd = (gp == 11);
    const bool ctxrow = u.pm < 32;
#pragma unroll
    for (int ai = 0; ai < 2; ++ai)
#pragma unroll
      for (int m = 0; m < 4; ++m) {
        const int row = row0 + ai * 128 + m * 16;
        float sc = 1.f;
        if (isq || isk) {
          float ss = 0.f;
#pragma unroll
          for (int bj = 0; bj < 2; ++bj)
#pragma unroll
            for (int n = 0; n < 2; ++n) { const f32x4 x = acc[ai][bj][m][n]; ss += (x[0] * x[0] + x[1] * x[1]) + (x[2] * x[2] + x[3] * x[3]); }
          ss += __shfl_xor(ss, 16); ss += __shfl_xor(ss, 32);
          sc = rsqrtf(ss * (1.f / 64.f) + 1e-6f);
          if (isq) sc *= 0.125f;
        }
        if (isqd) sc = 0.125f;
#pragma unroll
        for (int bj = 0; bj < 2; ++bj) {
          f32x4 v0 = acc[ai][bj][m][0] * sc, v1 = acc[ai][bj][m][1] * sc;
          const int c = cl + 32 * bj;
          if (isq || isk) {
            const float* gg = (isq ? qg : kg) + (c & 63);
            const f32x4 g0 = *(const f32x4*)gg, g1 = *(const f32x4*)(gg + 4);
            v0 = v0 * g0; v1 = v1 * g1;
          }
          u32x4 w; w.x = cvt_pk_bf16(v0[0], v0[1]); w.y = cvt_pk_bf16(v0[2], v0[3]); w.z = cvt_pk_bf16(v1[0], v1[1]); w.w = cvt_pk_bf16(v1[2], v1[3]);
          *(u32x4*)(P + (size_t)row * NPW + gp * 256 + c) = w;
          if ((isk || isv) && ctxrow) {
            const int b = row >> 8, s = row & 255, h = c >> 6, d = c & 63;
            float* o = (isk ? ck : cv) + ((((size_t)b * 4 + layer) * 4 + h) * 256 + s) * 64 + d;
            *(f32x4*)o = v0; *(f32x4*)(o + 4) = v1;
          }
        }
      }
  }
};
struct EpiOut {
  const float* xp; const float* xs; float* out; const float* mod; float* dst;
  __device__ __forceinline__ void operator()(const f32x4 (&acc)[2][2][4][2], const pg8::Unit& u, int wr, int wc, int fr, int fq) const {
    const int row0 = u.pm * 256 + wr * 64 + fr;
    const int c0 = u.pn * 256 + wc * 64 + 8 * fq;
    const float* gv = mod + (size_t)row_vec(u.pm * 256) * 3072 + 2048;
    const float* src = xp ? (u.pm < 32 ? xp : xs - (size_t)NCTXR * DM) : out;
#pragma unroll
    for (int bj = 0; bj < 2; ++bj) {
      const int c = c0 + 32 * bj;
      const f32x4 g0 = *(const f32x4*)(gv + c), g1 = *(const f32x4*)(gv + c + 4);
#pragma unroll
      for (int ai = 0; ai < 2; ++ai)
#pragma unroll
        for (int m = 0; m < 4; ++m) {
          const size_t off = (size_t)(row0 + ai * 128 + m * 16) * DM + c;
          const f32x4 x0 = *(const f32x4*)(src + off), x1 = *(const f32x4*)(src + off + 4);
          if (dst) { *(f32x4*)(dst + off) = x0 + g0 * acc[ai][bj][m][0];
            *(f32x4*)(dst + off + 4) = x1 + g1 * acc[ai][bj][m][1]; }
        }
    }
  }
};

__device__ __forceinline__ void phase_mod(const Params& p, float* part, unsigned char* lds) {
  const int tidx_ = otid(), bidx_ = obid(), gdim_ = ogdim(); (void)tidx_; (void)bidx_; (void)gdim_;
  const float* wmod = p.in[I_WMOD]; const float* c = p.in[I_C]; const float* cctx = p.in[I_CCTX];
  float* sl = (float*)lds;
  for (int it = bidx_; it < 4 * 6 * 16; it += gdim_) {
    const int l = it / 96, cb = (it % 96) / 16, ks = it % 16;
    const int col = cb * 512 + tidx_;
    __syncthreads();
    if (tidx_ < 320) { const int v = tidx_ >> 6, k = ks * 64 + (tidx_ & 63); sl[tidx_] = siluf(v == 0 ? cctx[k] : c[(v - 1) * DM + k]); }
    __syncthreads();
    float a[5] = {0.f, 0.f, 0.f, 0.f, 0.f};
    const float* wp = wmod + ((size_t)l * DM + ks * 64) * 3072 + col;
#pragma unroll 1
    for (int k0 = 0; k0 < 64; k0 += 16) {
      float w[16];
#pragma unroll
      for (int j = 0; j < 16; ++j) w[j] = wp[(size_t)(k0 + j) * 3072];
#pragma unroll
      for (int j = 0; j < 16; ++j)
#pragma unroll
        for (int v = 0; v < 5; ++v) a[v] += sl[v * 64 + k0 + j] * w[j];
    }
#pragma unroll
    for (int v = 0; v < 5; ++v) part[((size_t)ks * 20 + l * 5 + v) * 3072 + col] = a[v];
  }
  __syncthreads();
}
__device__ __forceinline__ void phase_mod_reduce(const Params& p, const float* part, float* mod) {
  const int tidx_ = otid(), bidx_ = obid(), gdim_ = ogdim(); (void)tidx_; (void)bidx_; (void)gdim_;
  const float* bmod = p.in[I_BMOD];
  for (int e = bidx_ * NTHREADS + tidx_; e < 20 * 3072; e += gdim_ * NTHREADS) {
    const int lv = e / 3072, col = e % 3072, l = lv / 5;
    float s = bmod[l * 3072 + col];
#pragma unroll
    for (int ks = 0; ks < 16; ++ks) s += part[((size_t)ks * 20 + lv) * 3072 + col];
    mod[e] = s;
  }
}

__device__ __forceinline__ void phase_norm(const Params& p, int layer, const float* mod_l, bf16_t* hN, bf16_t* WinT, bf16_t* WaT, bf16_t* WoutT, unsigned char* lds) {
  const int tidx_ = otid(), bidx_ = obid(), gdim_ = ogdim(); (void)tidx_; (void)bidx_; (void)gdim_;
  const int tid = tidx_, lane = tid & 63, wid = __builtin_amdgcn_readfirstlane(tid >> 6);
  const float* ng = p.in[I_NG] + layer * DM;
  const int rstep = gdim_ * 8;
  int row = bidx_ * 8 + wid;
  f32x4 vn[4];
  if (row < MROWS) { const float* x = (layer == 0) ? (row < NCTXR ? p.in[I_XP] + (size_t)row * DM : p.in[I_XS] + (size_t)(row - NCTXR) * DM) : p.out + (size_t)row * DM;
#pragma unroll
    for (int i = 0; i < 4; ++i) vn[i] = *(const f32x4*)(x + i * 256 + lane * 4); }
  for (; row < MROWS; row += rstep) {
    f32x4 v[4];
#pragma unroll
    for (int i = 0; i < 4; ++i) v[i] = vn[i];
    const int nrow = row + rstep;
    if (nrow < MROWS) { const float* x = (layer == 0) ? (nrow < NCTXR ? p.in[I_XP] + (size_t)nrow * DM : p.in[I_XS] + (size_t)(nrow - NCTXR) * DM) : p.out + (size_t)nrow * DM;
#pragma unroll
      for (int i = 0; i < 4; ++i) vn[i] = *(const f32x4*)(x + i * 256 + lane * 4); }
    const float* mv = mod_l + (size_t)row_vec(row) * 3072;
    float ss = 0.f;
#pragma unroll
    for (int i = 0; i < 4; ++i) ss += (v[i][0] * v[i][0] + v[i][1] * v[i][1]) + (v[i][2] * v[i][2] + v[i][3] * v[i][3]);
#pragma unroll
    for (int o = 1; o < 64; o <<= 1) ss += __shfl_xor(ss, o);
    const float rstd = rsqrtf(ss * (1.f / 1024.f) + 1e-6f);
#pragma unroll
    for (int i = 0; i < 4; ++i) {
      const int c = i * 256 + lane * 4;
      const f32x4 g = *(const f32x4*)(ng + c), sh = *(const f32x4*)(mv + c), scl = *(const f32x4*)(mv + 1024 + c);
      f32x4 y;
#pragma unroll
      for (int j = 0; j < 4; ++j) y[j] = v[i][j] * rstd * g[j] * (1.f + scl[j]) + sh[j];
      u32x2 w; w.x = cvt_pk_bf16(y[0], y[1]); w.y = cvt_pk_bf16(y[2], y[3]);
      *(u32x2*)(hN + (size_t)row * DM + c) = w;
    }
  }
}

__device__ __forceinline__ void phase_wconv(const Params& p, int layer, bf16_t* WinT, bf16_t* WaT, bf16_t* WoutT, unsigned char* lds, int b0, int nb) {
  const int tidx_ = otid(), bidx_ = obid(), gdim_ = ogdim(); (void)tidx_; (void)bidx_; (void)gdim_;
  const int tid = tidx_;
  if (bidx_ < b0 || bidx_ >= b0 + nb) return;
  float* tile = (float*)lds;
  const float* win = p.in[I_WIN] + (size_t)layer * DM * NIN; const float* wout = p.in[I_WOUT] + (size_t)layer * DM * DM;
  const int NT_IN = 16 * 57, NT_ALL = NT_IN + 16 * 16;
  for (int it = bidx_ - b0; it < NT_ALL; it += nb) {
    const bool isin = it < NT_IN; const int t2 = isin ? it : it - NT_IN;
    const int kt = t2 & 15, ntile = t2 >> 4; const int ncols = isin ? NIN : DM; const float* W = isin ? win : wout;
    __syncthreads();
#pragma unroll
    for (int i = 0; i < 8; ++i) { const int e = tid + i * 512, kk = e >> 6, nn = e & 63; const int n = ntile * 64 + nn; tile[kk * 65 + nn] = (n < ncols) ? W[(size_t)(kt * 64 + kk) * ncols + n] : 0.f; }
    __syncthreads();
    const int nn = tid >> 3, kseg = tid & 7, nl = ntile * 64 + nn;
    if (nl < ncols) {
      u32x4 w; float f[8];
#pragma unroll
      for (int j = 0; j < 8; ++j) f[j] = tile[(kseg * 8 + j) * 65 + nn];
      w.x = cvt_pk_bf16(f[0], f[1]); w.y = cvt_pk_bf16(f[2], f[3]); w.z = cvt_pk_bf16(f[4], f[5]); w.w = cvt_pk_bf16(f[6], f[7]);
      bf16_t* dst;
      if (isin && nl >= NPW) dst = WaT + (size_t)(nl - NPW) * DM;
      else {
        const int gl = nl >> 8, c = nl & 255;
        int gp = gl;
        if (isin) { const int l2p[14] = {0, 4, 5, 6, 1, 7, 8, 9, 2, 10, 11, 12, 3, 13}; gp = l2p[gl]; }
        const int wc = c >> 6, bj = (c >> 5) & 1, t = c & 31, fq = t >> 3, n = (t >> 2) & 1, j = t & 3;
        const int pr = bj * 128 + wc * 32 + n * 16 + fq * 4 + j;
        dst = (isin ? WinT : WoutT) + (size_t)(gp * 256 + pr) * DM;
      }
      *(u32x4*)(dst + kt * 64 + kseg * 8) = w;
    }
  }
  __syncthreads();
}


__device__ __forceinline__ void phase_cachecvt(const Params& p, bf16_t* CKb, bf16_t* CVb) {
  const int tidx_ = otid(), bidx_ = obid(), gdim_ = ogdim(); (void)tidx_; (void)bidx_; (void)gdim_;
  for (int e = bidx_ * NTHREADS + tidx_; e < 2 * 262144; e += gdim_ * NTHREADS) {
    const bool isv = e >= 262144; const int o = (isv ? e - 262144 : e) * 8;
    *(u32x4*)((isv ? CVb : CKb) + o) = __builtin_bit_cast(u32x4, ld_f32x8_as_bf16(p.in[isv ? I_CV : I_CK] + o));
  }
}

__device__ __forceinline__ void phase_afb(const bf16_t* hN, const bf16_t* WaT, float* aFB) {
  const int tidx_ = otid(), bidx_ = obid(), gdim_ = ogdim(); (void)tidx_; (void)bidx_; (void)gdim_;
  const int lane = tidx_ & 63, wid = __builtin_amdgcn_readfirstlane(tidx_ >> 6), rr = lane & 31, hh = lane >> 5;
  const int nheavy = (gdim_ == 256) ? 64 : 0;
  if (bidx_ < nheavy) return;
  for (int it = (bidx_ - nheavy) * 8 + wid; it < MROWS / 32; it += (gdim_ - nheavy) * 8) {
    const bf16_t* a = hN + (size_t)(it * 32 + rr) * DM + hh * 8; const bf16_t* b = WaT + (size_t)rr * DM + hh * 8;
    f32x16 acc = zero16();
#pragma unroll 8
    for (int kk = 0; kk < 64; ++kk) acc = mfma32(ld_frag16(a + kk * 16), ld_frag16(b + kk * 16), acc);
#pragma unroll
    for (int i = 0; i < 16; ++i) { const int r = (i & 3) + 8 * (i >> 2) + 4 * hh; aFB[(size_t)(it * 32 + r) * 32 + rr] = acc[i]; }
  }
}

__device__ __forceinline__ void attn_ctx(bf16_t* P, bf16_t* Y, unsigned char* lds) {
  const int tidx_ = otid(), bidx_ = obid(), gdim_ = ogdim(); (void)tidx_; (void)bidx_; (void)gdim_;
  const int tid = tidx_, lane = tid & 63, wid = __builtin_amdgcn_readfirstlane(tid >> 6), rr = lane & 31, hh = lane >> 5;
  bf16_t* Ks = (bf16_t*)lds; bf16_t* Vt = (bf16_t*)(lds + 36864);
  for (int it = (bidx_ + 128) % gdim_; it < 128; it += gdim_) {
    const int b = it >> 2, h = it & 3; const size_t rb = (size_t)b * 256;
    __syncthreads();
#pragma unroll
    for (int i = 0; i < 4; ++i) { const int c = tid + 512 * i, key = c >> 3, part = c & 7; *(u32x4*)(Ks + key * 72 + part * 8) = *(const u32x4*)(P + (rb + key) * NPW + PKA + h * 64 + part * 8); }
    { const int kq = tid >> 3, part = tid & 7; u32x4 v[4];
#pragma unroll
      for (int i = 0; i < 4; ++i) v[i] = *(const u32x4*)(P + (rb + 4 * kq + i) * NPW + PVA + h * 64 + part * 8);
#pragma unroll
      for (int e = 0; e < 8; ++e) { const int wi = e >> 1; const bool hi = e & 1; unsigned s[4];
#pragma unroll
        for (int i = 0; i < 4; ++i) s[i] = hi ? (v[i][wi] >> 16) : (v[i][wi] & 0xffffu);
        u32x2 w; w.x = s[0] | (s[1] << 16); w.y = s[2] | (s[3] << 16);
        *(u32x2*)(Vt + (part * 8 + e) * 264 + 4 * kq) = w; } }
    __syncthreads();
    const size_t qrow = rb + wid * 32 + rr;
    bf16x8 qf[4];
#pragma unroll
    for (int ks = 0; ks < 4; ++ks) qf[ks] = ld_frag16(P + qrow * NPW + PQ + h * 64 + ks * 16 + hh * 8);
    float m = -1e30f, l = 0.f;
    f32x16 o[2]; o[0] = zero16(); o[1] = zero16();
#pragma unroll 1
    for (int half = 0; half < 2; ++half) {
      f32x16 acc[4];
#pragma unroll
      for (int j = 0; j < 4; ++j) { acc[j] = zero16(); const int kt = half * 4 + j;
#pragma unroll
        for (int ks = 0; ks < 4; ++ks) acc[j] = mfma32(ld_frag16(Ks + (kt * 32 + rr) * 72 + ks * 16 + hh * 8), qf[ks], acc[j]); }
      float mx = m;
#pragma unroll
      for (int j = 0; j < 4; ++j)
#pragma unroll
        for (int i = 0; i < 16; ++i) mx = fmaxf(mx, acc[j][i]);
      mx = fmaxf(mx, __shfl_xor(mx, 32));
      const float sc = __expf(m - mx); m = mx; l *= sc;
#pragma unroll
      for (int i = 0; i < 16; ++i) { o[0][i] *= sc; o[1][i] *= sc; }
#pragma unroll
      for (int j = 0; j < 4; ++j)
#pragma unroll
        for (int i = 0; i < 16; ++i) { const float e = __expf(acc[j][i] - mx); acc[j][i] = e; l += e; }
#pragma unroll
      for (int j = 0; j < 4; ++j)
#pragma unroll
        for (int s = 0; s < 2; ++s) { const bf16x8 pb = pack8(acc[j], s); const int kt = half * 4 + j;
#pragma unroll
          for (int dt = 0; dt < 2; ++dt) { const bf16_t* vp = Vt + (dt * 32 + rr) * 264 + kt * 32 + 16 * s + 4 * hh; o[dt] = mfma32(ld_frag8x2(vp, vp + 8), pb, o[dt]); } }
    }
    l += __shfl_xor(l, 32);
    const float inv = 1.f / l;
#pragma unroll
    for (int dt = 0; dt < 2; ++dt)
#pragma unroll
      for (int g4 = 0; g4 < 4; ++g4) { const int d = dt * 32 + 8 * g4 + 4 * hh;
        const u32x2 gw = *(const u32x2*)(P + qrow * NPW + PGA + h * 64 + d);
        u32x2 w; w.x = cvt_pk_bf16(o[dt][4 * g4] * inv * siluf(bflo(gw.x)), o[dt][4 * g4 + 1] * inv * siluf(bfhi(gw.x))); w.y = cvt_pk_bf16(o[dt][4 * g4 + 2] * inv * siluf(bflo(gw.y)), o[dt][4 * g4 + 3] * inv * siluf(bfhi(gw.y)));
        if (Y) *(u32x2*)(Y + qrow * NPW + PQ + h * 64 + d) = w; }
  }
  __syncthreads();
}

template <int MODE>
__device__ __forceinline__ void ad_tile(const bf16_t* Kt, const bf16_t* Vt_, const bf16x8 (&qf)[4], const float* brow, int cs, int rr, int hh, float& mx, float& l, f32x16 (&o)[2]) {
  f32x16 acc[2];
#pragma unroll
  for (int sub = 0; sub < 2; ++sub) { acc[sub] = zero16();
#pragma unroll
    for (int ks = 0; ks < 4; ++ks) acc[sub] = mfma32(ld_frag16(Kt + (sub * 32 + rr) * 72 + ks * 16 + hh * 8), qf[ks], acc[sub]); }
  float m2 = mx;
#pragma unroll
  for (int sub = 0; sub < 2; ++sub)
#pragma unroll
    for (int i = 0; i < 16; ++i) {
      const bool act = (MODE == 0) || (MODE == 1 ? (sub == 0 || i < 4) : (sub == 1 || i >= 12));
      if (act) {
        if (MODE != 0) { const int kc = sub * 32 + (i & 3) + 8 * (i >> 2) + 4 * hh; const bool ok = (kc >= cs) && (kc < cs + 16); acc[sub][i] = ok ? acc[sub][i] + brow[kc] : -1e30f; }
        m2 = fmaxf(m2, acc[sub][i]);
      }
    }
  m2 = fmaxf(m2, __shfl_xor(m2, 32));
  if (__any(m2 > mx + 8.f)) {
    const float sc = __expf(mx - m2); mx = m2; l *= sc;
#pragma unroll
    for (int i = 0; i < 16; ++i) { o[0][i] *= sc; o[1][i] *= sc; }
  }
#pragma unroll
  for (int sub = 0; sub < 2; ++sub)
#pragma unroll
    for (int i = 0; i < 16; ++i) {
      const bool act = (MODE == 0) || (MODE == 1 ? (sub == 0 || i < 4) : (sub == 1 || i >= 12));
      if (act) { const float e = __expf(acc[sub][i] - mx); acc[sub][i] = e; l += e; } else acc[sub][i] = 0.f;
    }
#pragma unroll
  for (int sub = 0; sub < 2; ++sub)
#pragma unroll
    for (int s = 0; s < 2; ++s) {
      const bool need = (MODE == 0) || (MODE == 1 ? (sub == 0 || s == 0) : (sub == 1 || s == 1));
      if (need) { const bf16x8 pb = pack8(acc[sub], s);
#pragma unroll
        for (int dt = 0; dt < 2; ++dt) { const bf16_t* vp = Vt_ + (dt * 32 + rr) * 72 + sub * 32 + 16 * s + 4 * hh; o[dt] = mfma32(ld_frag8x2(vp, vp + 8), pb, o[dt]); } }
    }
}

__device__ __forceinline__ void attn_den(const Params& p, int layer, bf16_t* P, bf16_t* Y, unsigned char* lds) {
  const int tidx_ = otid(), bidx_ = obid(), gdim_ = ogdim(); (void)tidx_; (void)bidx_; (void)gdim_;
  const int tid = tidx_, lane = tid & 63, wid = __builtin_amdgcn_readfirstlane(tid >> 6), rr = lane & 31, hh = lane >> 5;
  bf16_t* Kb = (bf16_t*)lds;
  bf16_t* Vb = (bf16_t*)(lds + 18432);
  float* rpbs = (float*)(lds + 36864);
  const bf16_t* CKb = (const bf16_t*)(p.ws + WS_CKB); const bf16_t* CVb = (const bf16_t*)(p.ws + WS_CVB); const float* rpb = p.in[I_RPB];
  const int skey = tid >> 3, spart = tid & 7;
  for (int it = bidx_; it < 256; it += gdim_) {
    const int b = it >> 6, h = (it >> 4) & 3, r0 = (it & 15) * 4;
    const size_t rb = (size_t)NCTXR + (size_t)b * 4096;
    const size_t cbase = (((size_t)b * 4 + layer) * 4 + h) * 512 * 64;
    const int r = r0 + (wid >> 1), qhalf = wid & 1;
    const int rs = min(max(r - 4, 0), 56);
    const int R0 = min(max(r0 - 4, 0), 56), nlat = min(max(r0 - 1, 0), 56) + 8 - R0, T = nlat + 8;
    __syncthreads();
    if (tid < 480) { const int dr = tid >> 5, dc = tid & 31; rpbs[tid] = dc < 31 ? rpb[(((size_t)layer * 4 + h) * 15 + dr) * 31 + dc] : 0.f; }
    const size_t qtok = rb + (size_t)r * 64 + qhalf * 32 + rr;
    bf16x8 qf[4];
#pragma unroll
    for (int ks = 0; ks < 4; ++ks) qf[ks] = ld_frag16(P + qtok * NPW + PQ + h * 64 + ks * 16 + hh * 8);
    const int qc = qhalf * 32 + rr; const int cs = min(max(qc - 8, 0), 48);
    u32x4 kA, vA, kB, vB;
#define AD_LOAD(j, kreg, vreg) do { if ((j) < nlat) { const size_t t0 = rb + (size_t)(R0 + (j)) * 64; \
        kreg = *(const u32x4*)(P + (t0 + skey) * NPW + PKA + h * 64 + spart * 8); \
        vreg = *(const u32x4*)(P + (t0 + skey) * NPW + PVA + h * 64 + spart * 8); \
      } else { const int c_ = (j) - nlat; \
        kreg = *(const u32x4*)(CKb + cbase + (size_t)(c_ * 64 + skey) * 64 + spart * 8); \
        vreg = *(const u32x4*)(CVb + cbase + (size_t)(c_ * 64 + skey) * 64 + spart * 8); } } while (0)
#define AD_WRITE(buf, kreg, vreg) do { *(u32x4*)(Kb + (buf) * 4608 + skey * 72 + spart * 8) = kreg; \
      _Pragma("unroll") for (int e_ = 0; e_ < 8; ++e_) { const unsigned w_ = vreg[e_ >> 1]; \
        Vb[(buf) * 4608 + (spart * 8 + e_) * 72 + skey] = (bf16_t)((e_ & 1) ? (w_ >> 16) : (w_ & 0xffffu)); } } while (0)
#define AD_COMPUTE(j) do { const int buf = (j) & 1; const bool lat = (j) < nlat; const int R = R0 + (j); \
      const bool use = !lat || (R >= rs && R < rs + 8); \
      if (use) { const bf16_t* Kt = Kb + buf * 4608; const bf16_t* Vt_ = Vb + buf * 4608; const float* brow = rpbs + (R - r + 7) * 32 + 15 - qc; \
        if (!lat) ad_tile<0>(Kt, Vt_, qf, brow, cs, rr, hh, mx, l, o); \
        else if (qhalf == 0) ad_tile<1>(Kt, Vt_, qf, brow, cs, rr, hh, mx, l, o); \
        else ad_tile<2>(Kt, Vt_, qf, brow, cs, rr, hh, mx, l, o); } } while (0)
    AD_LOAD(0, kB, vB);
    AD_WRITE(0, kB, vB);
    AD_LOAD(1, kA, vA);
    __syncthreads();
    float mx = -1e30f, l = 0.f;
    f32x16 o[2]; o[0] = zero16(); o[1] = zero16();
#pragma unroll 1
    for (int j = 0; j < T; j += 2) {
      if (j + 2 < T) AD_LOAD(j + 2, kB, vB);
      AD_COMPUTE(j);
      if (j + 1 < T) AD_WRITE(1, kA, vA);
      __syncthreads();
      if (j + 1 < T) {
        if (j + 3 < T) AD_LOAD(j + 3, kA, vA);
        AD_COMPUTE(j + 1);
        if (j + 2 < T) AD_WRITE(0, kB, vB);
        __syncthreads();
      }
    }
#undef AD_LOAD
#undef AD_WRITE
#undef AD_COMPUTE
    l += __shfl_xor(l, 32);
    const float inv = 1.f / l;
#pragma unroll
    for (int dt = 0; dt < 2; ++dt)
#pragma unroll
      for (int g4 = 0; g4 < 4; ++g4) { const int d = dt * 32 + 8 * g4 + 4 * hh;
        const u32x2 gw = *(const u32x2*)(P + qtok * NPW + PGA + h * 64 + d);
        u32x2 w; w.x = cvt_pk_bf16(o[dt][4 * g4] * inv * siluf(bflo(gw.x)), o[dt][4 * g4 + 1] * inv * siluf(bfhi(gw.x))); w.y = cvt_pk_bf16(o[dt][4 * g4 + 2] * inv * siluf(bflo(gw.y)), o[dt][4 * g4 + 3] * inv * siluf(bfhi(gw.y)));
        if (Y) *(u32x2*)(Y + qtok * NPW + PQ + h * 64 + d) = w; }
  }
  __syncthreads();
}

__device__ __forceinline__ void conv_mix(const Params& p, int layer, bf16_t* P, bf16_t* Y) {
  const int tidx_ = otid(), bidx_ = obid(), gdim_ = ogdim(); (void)tidx_; (void)bidx_; (void)gdim_;
  const float* cw = p.in[I_CONV] + layer * 768;
  const long long total = (long long)MROWS * 32, stride = (long long)gdim_ * NTHREADS;
  for (long long e0 = (long long)bidx_ * NTHREADS + tidx_; e0 < total; e0 += 2 * stride) {
    u32x4 cv[2][3], hv[2][3], bv[2], gv[2]; float ml[2], mr[2]; int rowv[2], cc[2]; bool live[2];
#pragma unroll
    for (int q = 0; q < 2; ++q) {
      const long long e = e0 + q * stride; live[q] = e < total; const long long ee = live[q] ? e : e0;
      const int row = (int)(ee >> 5), c = (int)(ee & 31) * 8; rowv[q] = row; cc[q] = c;
      int s, S; if (row < NCTXR) { s = row & 255; S = 256; } else { s = (row - NCTXR) & 4095; S = 4096; }
      const bool hl = s > 0, hr = s < S - 1; ml[q] = hl ? 1.f : 0.f; mr[q] = hr ? 1.f : 0.f;
      const bf16_t* pr = P + (size_t)row * NPW; const bf16_t* pl = hl ? pr - NPW : pr; const bf16_t* pn = hr ? pr + NPW : pr;
      cv[q][0] = *(const u32x4*)(pl + PCB + c); hv[q][0] = *(const u32x4*)(pl + PHB + c);
      cv[q][1] = *(const u32x4*)(pr + PCB + c); hv[q][1] = *(const u32x4*)(pr + PHB + c);
      cv[q][2] = *(const u32x4*)(pn + PCB + c); hv[q][2] = *(const u32x4*)(pn + PHB + c);
      bv[q] = *(const u32x4*)(pr + PBB + c); gv[q] = *(const u32x4*)(pr + PGB + c);
    }
#pragma unroll
    for (int q = 0; q < 2; ++q) {
      const int c = cc[q];
      float y[8];
#pragma unroll
      for (int j = 0; j < 8; ++j) {
        const int wj = j >> 1; const bool hi = j & 1;
        const float u0 = (hi ? bfhi(cv[q][0][wj]) * bfhi(hv[q][0][wj]) : bflo(cv[q][0][wj]) * bflo(hv[q][0][wj])) * ml[q];
        const float u1 = hi ? bfhi(cv[q][1][wj]) * bfhi(hv[q][1][wj]) : bflo(cv[q][1][wj]) * bflo(hv[q][1][wj]);
        const float u2 = (hi ? bfhi(cv[q][2][wj]) * bfhi(hv[q][2][wj]) : bflo(cv[q][2][wj]) * bflo(hv[q][2][wj])) * mr[q];
        const float conv = u0 * cw[c + j] + u1 * cw[256 + c + j] + u2 * cw[512 + c + j];
        const float bb = hi ? bfhi(bv[q][wj]) : bflo(bv[q][wj]); const float gg = siluf(hi ? bfhi(gv[q][wj]) : bflo(gv[q][wj]));
        y[j] = bb * conv * gg;
      }
      u32x4 w; w.x = cvt_pk_bf16(y[0], y[1]); w.y = cvt_pk_bf16(y[2], y[3]); w.z = cvt_pk_bf16(y[4], y[5]); w.w = cvt_pk_bf16(y[6], y[7]);
      if (Y && live[q]) *(u32x4*)(Y + (size_t)rowv[q] * NPW + PBB + c) = w;
    }
  }
}

__device__ __forceinline__ void fourier_tables(unsigned char* lds) {
  const int tidx_ = otid(), bidx_ = obid(), gdim_ = ogdim(); (void)tidx_; (void)bidx_; (void)gdim_;
  bf16_t* T = (bf16_t*)lds;
  for (int e = tidx_; e < 4096; e += NTHREADS) { const int a = e >> 6, b = e & 63; const float x = (float)((a * b) & 63) * (1.f / 64.f);
    T[a * 72 + b] = f2bf(__builtin_amdgcn_cosf(x)); T[4608 + a * 72 + b] = f2bf(__builtin_amdgcn_sinf(x));
    const bool in4 = (a < 32) && (b < 32) && ((a >> 2) == (b >> 2)); const float y = (float)(((a & 3) * (b & 3)) & 3) * 0.25f;
    T[9216 + a * 72 + b] = in4 ? f2bf(__builtin_amdgcn_cosf(y)) : (bf16_t)0; T[13824 + a * 72 + b] = in4 ? f2bf(__builtin_amdgcn_sinf(y)) : (bf16_t)0; }
}
__device__ __forceinline__ bf16x8 neg_bf16x8(bf16x8 v) { u32x4 w = __builtin_bit_cast(u32x4, v); w.x ^= 0x80008000u; w.y ^= 0x80008000u; w.z ^= 0x80008000u; w.w ^= 0x80008000u; return as_bf16x8(w); }

template <bool DEN>
__device__ __forceinline__ void fourier1_item(int t2, const bf16_t* P, bf16_t* Zr, bf16_t* Zi, unsigned char* lds) {
  const int tidx_ = otid(), bidx_ = obid(), gdim_ = ogdim(); (void)tidx_; (void)bidx_; (void)gdim_;
  const int tid = tidx_, lane = tid & 63, wid = __builtin_amdgcn_readfirstlane(tid >> 6), rr = lane & 31, hh = lane >> 5;
  const bf16_t* T = (const bf16_t*)lds;
  bf16_t* Xr = (bf16_t*)(lds + 36864); bf16_t* Xi = (bf16_t*)(lds + 36864 + 32768);
  constexpr int NS1 = DEN ? 64 : 4, NKAT = DEN ? 2 : 1, NSS = DEN ? 4 : 1, NST = DEN ? 2 : 1;
  const int jh = t2 & 1, sblk = (t2 >> 1) & 7, bg = t2 >> 4, g = bg & 3, b = bg >> 2;
  const size_t rb = DEN ? (size_t)NCTXR + (size_t)b * 4096 : (size_t)b * 256;
  const int s2 = sblk * 8 + wid;
  const bf16_t* Tc = DEN ? T : T + 9216; const bf16_t* Ts = DEN ? T + 4608 : T + 13824;
  f32x16 uc[NST], us[NST];
  {
    bf16x8 bc[4], bs[4];
#pragma unroll
    for (int ks = 0; ks < 4; ++ks) { bc[ks] = ld_frag16(T + (jh * 32 + rr) * 72 + ks * 16 + hh * 8); bs[ks] = ld_frag16(T + 4608 + (jh * 32 + rr) * 72 + ks * 16 + hh * 8); }
#pragma unroll
    for (int st = 0; st < NST; ++st) { uc[st] = zero16(); us[st] = zero16();
      const int s1 = st * 32 + rr; const bool valid = s1 < NS1;
      const bf16_t* up = P + (rb + (size_t)(valid ? s1 : 0) * 64 + s2) * NPW + PUC + g * 64 + hh * 8;
#pragma unroll
      for (int ks = 0; ks < 4; ++ks) { u32x4 raw = *(const u32x4*)(up + ks * 16); if (!valid) raw = (u32x4){0u, 0u, 0u, 0u}; const bf16x8 a = as_bf16x8(raw); uc[st] = mfma32(a, bc[ks], uc[st]); us[st] = mfma32(a, bs[ks], us[st]); } }
  }
  bf16x8 puc[NSS], pus[NSS], pun[NSS];
#pragma unroll
  for (int s = 0; s < NSS; ++s) { puc[s] = pack8(uc[s >> 1], s & 1); pus[s] = pack8(us[s >> 1], s & 1); pun[s] = neg_bf16x8(pus[s]); }
  constexpr float nrm = DEN ? (1.f / 512.f) : (1.f / 128.f), invS = DEN ? (1.f / 4096.f) : (1.f / 256.f);
  __syncthreads();
#pragma unroll
  for (int kat = 0; kat < NKAT; ++kat) {
    f32x16 yr = zero16(), ys = zero16();
#pragma unroll
    for (int s = 0; s < NSS; ++s) {
      const bf16_t* tc = Tc + (kat * 32 + rr) * 72 + 16 * s + 4 * hh; const bf16_t* ts = Ts + (kat * 32 + rr) * 72 + 16 * s + 4 * hh;
      const bf16x8 ac = ld_frag8x2(tc, tc + 8), as = ld_frag8x2(ts, ts + 8);
      yr = mfma32(ac, puc[s], yr); yr = mfma32(as, pun[s], yr);
      ys = mfma32(ac, pus[s], ys); ys = mfma32(as, puc[s], ys);
    }
#pragma unroll
    for (int i = 0; i < 16; ++i) { const int ka = kat * 32 + (i & 3) + 8 * (i >> 2) + 4 * hh;
      const float th = (float)((ka * s2) & (DEN ? 4095 : 255)) * invS; const float c = __builtin_amdgcn_cosf(th), s = __builtin_amdgcn_sinf(th);
      const float zr = (yr[i] * c - ys[i] * s) * nrm, zi = (-ys[i] * c - yr[i] * s) * nrm;
      Xr[(ka * 32 + rr) * 8 + wid] = f2bf(zr); Xi[(ka * 32 + rr) * 8 + wid] = f2bf(zi); }
  }
  __syncthreads();
  { constexpr int nka = DEN ? 64 : 4; const size_t zb = DEN ? (size_t)512 + (size_t)bg * 64 : (size_t)bg * 4;
    for (int c = tid; c < nka * 32; c += NTHREADS) { const int ka = c >> 5, jl = c & 31;
      const size_t zo = ((zb + ka) * 64 + jh * 32 + jl) * 64 + sblk * 8;
      *(u32x4*)(Zr + zo) = *(const u32x4*)(Xr + c * 8); *(u32x4*)(Zi + zo) = *(const u32x4*)(Xi + c * 8); } }
}
__device__ __forceinline__ void fourier1_ctx(const bf16_t* P, bf16_t* Zr, bf16_t* Zi, unsigned char* lds) {
  const int tidx_ = otid(), bidx_ = obid(), gdim_ = ogdim(); (void)tidx_; (void)bidx_; (void)gdim_;
  const int tid = tidx_, lane = tid & 63, wid = __builtin_amdgcn_readfirstlane(tid >> 6), rr = lane & 31, hh = lane >> 5;
  const bf16_t* T = (const bf16_t*)lds;
  for (int it = bidx_ * 8 + wid; it < 1024; it += gdim_ * 8) {
    const int sblk = it & 7, bg = it >> 3, g = bg & 3, b = bg >> 2;
    const size_t rb = (size_t)b * 256;
    const bf16_t* up = P + (rb + (size_t)(rr & 3) * 64 + sblk * 8 + (rr >> 2)) * NPW + PUC + g * 64 + hh * 8;
    bf16x8 a[4];
#pragma unroll
    for (int ks = 0; ks < 4; ++ks) a[ks] = ld_frag16(up + ks * 16);
#pragma unroll 1
    for (int jt = 0; jt < 2; ++jt) {
      f32x16 uc = zero16(), us = zero16();
#pragma unroll
      for (int ks = 0; ks < 4; ++ks) { uc = mfma32(a[ks], ld_frag16(T + (jt * 32 + rr) * 72 + ks * 16 + hh * 8), uc); us = mfma32(a[ks], ld_frag16(T + 4608 + (jt * 32 + rr) * 72 + ks * 16 + hh * 8), us); }
      f32x16 yr = zero16(), ys = zero16();
#pragma unroll
      for (int s = 0; s < 2; ++s) {
        const bf16x8 puc = pack8(uc, s), pus = pack8(us, s), pun = neg_bf16x8(pus);
        const bf16_t* tc = T + 9216 + rr * 72 + 16 * s + 4 * hh; const bf16_t* ts = T + 13824 + rr * 72 + 16 * s + 4 * hh;
        const bf16x8 ac = ld_frag8x2(tc, tc + 8), as = ld_frag8x2(ts, ts + 8);
        yr = mfma32(ac, puc, yr); yr = mfma32(as, pun, yr);
        ys = mfma32(ac, pus, ys); ys = mfma32(as, puc, ys);
      }
      float zr[16], zi[16];
#pragma unroll
      for (int i = 0; i < 16; ++i) { const int ka = i & 3, s2 = sblk * 8 + 2 * (i >> 2) + hh;
        const float th = (float)((ka * s2) & 255) * (1.f / 256.f); const float c = __builtin_amdgcn_cosf(th), s = __builtin_amdgcn_sinf(th);
        zr[i] = (yr[i] * c - ys[i] * s) * (1.f / 128.f); zi[i] = (-ys[i] * c - yr[i] * s) * (1.f / 128.f); }
#pragma unroll
      for (int ka = 0; ka < 4; ++ka) {
        u32x4 wr_, wi_;
#pragma unroll
        for (int m = 0; m < 4; ++m) {
          const float mr = zr[ka + 4 * m], mi = zi[ka + 4 * m];
          const float orr = __shfl_xor(mr, 32), oi = __shfl_xor(mi, 32);
          wr_[m] = hh ? cvt_pk_bf16(orr, mr) : cvt_pk_bf16(mr, orr);
          wi_[m] = hh ? cvt_pk_bf16(oi, mi) : cvt_pk_bf16(mi, oi);
        }
        const size_t zo = (((size_t)bg * 4 + ka) * 64 + jt * 32 + rr) * 64 + sblk * 8;
        if (hh == 0) *(u32x4*)(Zr + zo) = wr_; else *(u32x4*)(Zi + zo) = wi_;
      }
    }
  }
}
__device__ __forceinline__ void fourier1(const bf16_t* P, bf16_t* Zr, bf16_t* Zi, unsigned char* lds) {
  const int tidx_ = otid(), bidx_ = obid(), gdim_ = ogdim(); (void)tidx_; (void)bidx_; (void)gdim_;
  __syncthreads();
  fourier_tables(lds);
  __syncthreads();
#pragma unroll 1
  for (int it = bidx_; it < 256; it += gdim_) fourier1_item<true>(it, P, Zr, Zi, lds);
  fourier1_ctx(P, Zr, Zi, lds);
  __syncthreads();
}

__device__ __forceinline__ void fourier2(bf16_t* P, const bf16_t* Zr, const bf16_t* Zi, unsigned char* lds) {
  const int tidx_ = otid(), bidx_ = obid(), gdim_ = ogdim(); (void)tidx_; (void)bidx_; (void)gdim_;
  const int tid = tidx_, lane = tid & 63, wid = __builtin_amdgcn_readfirstlane(tid >> 6), rr = lane & 31, hh = lane >> 5;
  const bf16_t* T = (const bf16_t*)lds;
  __syncthreads();
  fourier_tables(lds);
  __syncthreads();
  for (int it = bidx_ * 8 + wid; it < 1024 + 512; it += gdim_ * 8) {
    const bool den = it < 1024; const int t2 = den ? it : it - 1024;
    int ka, bg; if (den) { ka = t2 & 63; bg = t2 >> 6; } else { ka = t2 & 3; bg = t2 >> 2; }
    const int g = bg & 3, b = bg >> 2; const int NS1 = den ? 64 : 4;
    const size_t rb = den ? (size_t)NCTXR + (size_t)b * 4096 : (size_t)b * 256;
    const size_t zb = ((den ? (size_t)512 + (size_t)bg * 64 : (size_t)bg * 4) + ka) * 4096;
    bf16x8 zr[2][4], zi[2][4]; u32x2 gwv[2][2][4];
#pragma unroll
    for (int jt = 0; jt < 2; ++jt)
#pragma unroll
      for (int s = 0; s < 4; ++s) { const size_t o = zb + (size_t)(jt * 32 + rr) * 64 + 16 * s + 8 * hh; zr[jt][s] = ld_frag16(Zr + o); zi[jt][s] = ld_frag16(Zi + o); }
#pragma unroll
    for (int jt = 0; jt < 2; ++jt)
#pragma unroll
      for (int kbt = 0; kbt < 2; ++kbt) { const size_t tok = rb + ka + (size_t)NS1 * (kbt * 32 + rr);
#pragma unroll
        for (int g4 = 0; g4 < 4; ++g4) gwv[jt][kbt][g4] = *(const u32x2*)(P + tok * NPW + PGC + g * 64 + jt * 32 + 8 * g4 + 4 * hh); }
#pragma unroll
    for (int jt = 0; jt < 2; ++jt) {
#pragma unroll
      for (int kbt = 0; kbt < 2; ++kbt) {
        f32x16 x = zero16();
#pragma unroll
        for (int s = 0; s < 4; ++s) { x = mfma32(zr[jt][s], ld_frag16(T + (kbt * 32 + rr) * 72 + 16 * s + 8 * hh), x); x = mfma32(zi[jt][s], ld_frag16(T + 4608 + (kbt * 32 + rr) * 72 + 16 * s + 8 * hh), x); }
        const size_t tok = rb + ka + (size_t)NS1 * (kbt * 32 + rr);
#pragma unroll
        for (int g4 = 0; g4 < 4; ++g4) { const int ch = g * 64 + jt * 32 + 8 * g4 + 4 * hh;
          const u32x2 gw = gwv[jt][kbt][g4];
          u32x2 w; w.x = cvt_pk_bf16(x[4 * g4] * siluf(bflo(gw.x)), x[4 * g4 + 1] * siluf(bfhi(gw.x))); w.y = cvt_pk_bf16(x[4 * g4 + 2] * siluf(bflo(gw.y)), x[4 * g4 + 3] * siluf(bfhi(gw.y)));
          *(u32x2*)(P + tok * NPW + PUC + ch) = w; }
      }
    }
  }
}

__device__ __forceinline__ int gla_slot(bool den, int b, int h, int dir) { return den ? 1024 + ((b * 4 + h) * 2 + dir) * 64 : ((b * 4 + h) * 2 + dir) * 4; }
__device__ __forceinline__ void gla_decay(const Params& p, int layer, int h, size_t rb, const float* aFB, float* SEGv, int tt, int dkt, int rr, int hh, float (&G)[2][16], float (&tot)[2]) {
  const int dkc = dkt * 32 + rr;
  const int tau = 16 * ((rr >> 2) & 1) + (rr & 3) + 4 * (rr >> 3);
#pragma unroll
  for (int dir = 0; dir < 2; ++dir) {
    const float* up = p.in[dir ? I_UPB : I_UPF] + (size_t)layer * 16 * 256 + h * 64 + dkc + (size_t)(8 * hh) * 256;
    u32x4 ub; ub.x = cvt_pk_bf16(up[0], up[256]); ub.y = cvt_pk_bf16(up[512], up[768]); ub.z = cvt_pk_bf16(up[1024], up[1280]); ub.w = cvt_pk_bf16(up[1536], up[1792]);
    const float bias = p.in[dir ? I_BB : I_BF][layer * 256 + h * 64 + dkc];
    const bf16x8 af = ld_f32x8_as_bf16(aFB + (rb + tt * 32 + tau) * 32 + dir * 16 + 8 * hh);
    const f32x16 z = mfma32(af, as_bf16x8(ub), zero16());
    float run = 0.f;
    if (dir == 0) {
#pragma unroll
      for (int i = 0; i < 16; ++i) { run += logsigf(z[i] + bias) * (1.f / 16.f); G[0][i] = run; }
    } else {
#pragma unroll
      for (int i = 15; i >= 0; --i) { run += logsigf(z[i] + bias) * (1.f / 16.f); G[1][i] = run; }
    }
    SEGv[(dir * 4 + tt * 2 + hh) * 64 + dkc] = run;
  }
  __syncthreads();
#pragma unroll
  for (int dir = 0; dir < 2; ++dir) {
    float run = 0.f, excl = 0.f, incl = 0.f;
#pragma unroll
    for (int s = 0; s < 4; ++s) { const float v = SEGv[(dir * 4 + s) * 64 + dkc]; const bool mine = (s == tt * 2 + hh); excl = mine ? run : excl; incl = mine ? run + v : incl; run += v; }
    tot[dir] = run;
    const float off = dir ? (run - incl) : excl;
#pragma unroll
    for (int i = 0; i < 16; ++i) G[dir][i] += off;
  }
}
__device__ __forceinline__ void gla1(const Params& p, int layer, const bf16_t* P, const float* aFB, bf16_t* ST, float* DEC, unsigned char* lds) {
  const int tidx_ = otid(), bidx_ = obid(), gdim_ = ogdim(); (void)tidx_; (void)bidx_; (void)gdim_;
  const int tid = tidx_, lane = tid & 63, wid = __builtin_amdgcn_readfirstlane(tid >> 6), rr = lane & 31, hh = lane >> 5;
  const int half = wid >> 2, lw = wid & 3, ltid = tid & 255;
  unsigned char* lb = lds + half * 40960;
  bf16_t* KE = (bf16_t*)lb;
  bf16_t* VT = (bf16_t*)(lb + 18432);
  float* SEGv = (float*)(lb + 27648);
  const int tt = lw & 1, dkt = lw >> 1, dkc = dkt * 32 + rr;
  for (int it2 = bidx_; it2 < 768; it2 += gdim_) {
    const int it = it2 * 2 + half;
    bool den; int b, h, n, NC;
    if (it < 1024) { den = true; NC = 64; n = it & 63; h = (it >> 6) & 3; b = it >> 8; }
    else { const int t2 = it - 1024; den = false; NC = 4; n = t2 & 3; h = (t2 >> 2) & 3; b = t2 >> 4; }
    const size_t rb = (den ? (size_t)NCTXR + (size_t)b * 4096 : (size_t)b * 256) + (size_t)n * 64;
    float kv[16];
#pragma unroll
    for (int i = 0; i < 16; ++i) kv[i] = bf2f(P[(rb + tt * 32 + 16 * hh + i) * NPW + PKD + h * 64 + dkc]);
    u32x4 vst[4];
    if (ltid < 128) {
#pragma unroll
      for (int i = 0; i < 4; ++i) vst[i] = *(const u32x4*)(P + (rb + 4 * (ltid >> 3) + i) * NPW + PVD + h * 64 + (ltid & 7) * 8);
    }
    __syncthreads();
    float G[2][16], tot[2];
    gla_decay(p, layer, h, rb, aFB, SEGv, tt, dkt, rr, hh, G, tot);
#pragma unroll
    for (int dir = 0; dir < 2; ++dir) {
      { float e[16];
#pragma unroll
        for (int q = 0; q < 16; ++q) e[q] = kv[q] * __expf(tot[dir] - G[dir][q]);
        u32x4 w0, w1;
        w0.x = cvt_pk_bf16(e[0], e[1]); w0.y = cvt_pk_bf16(e[2], e[3]); w0.z = cvt_pk_bf16(e[4], e[5]); w0.w = cvt_pk_bf16(e[6], e[7]);
        w1.x = cvt_pk_bf16(e[8], e[9]); w1.y = cvt_pk_bf16(e[10], e[11]); w1.z = cvt_pk_bf16(e[12], e[13]); w1.w = cvt_pk_bf16(e[14], e[15]);
        *(u32x4*)(KE + dir * 4608 + dkc * 72 + tt * 32 + 16 * hh) = w0; *(u32x4*)(KE + dir * 4608 + dkc * 72 + tt * 32 + 16 * hh + 8) = w1; }
      if (tt == 0 && hh == 0) { const int slot = gla_slot(den, b, h, dir) + (dir ? NC - 1 - n : n); DEC[(size_t)slot * 64 + dkc] = __expf(tot[dir]); }
    }
    if (ltid < 128) {
      const int tq2 = ltid >> 3, part = ltid & 7;
#pragma unroll
      for (int e = 0; e < 8; ++e) { const int wi = e >> 1; const bool hi = e & 1; unsigned s[4];
#pragma unroll
        for (int i = 0; i < 4; ++i) s[i] = hi ? (vst[i][wi] >> 16) : (vst[i][wi] & 0xffffu);
        u32x2 w; w.x = s[0] | (s[1] << 16); w.y = s[2] | (s[3] << 16);
        *(u32x2*)(VT + (part * 8 + e) * 72 + 4 * tq2) = w; }
    }
    __syncthreads();
    {
      const int dkt2 = lw & 1, dvt = lw >> 1;
#pragma unroll
      for (int dir = 0; dir < 2; ++dir) {
        f32x16 acc = zero16();
#pragma unroll
        for (int ks = 0; ks < 4; ++ks) acc = mfma32(ld_frag16(KE + dir * 4608 + (dkt2 * 32 + rr) * 72 + ks * 16 + hh * 8), ld_frag16(VT + (dvt * 32 + rr) * 72 + ks * 16 + hh * 8), acc);
        const int slot = gla_slot(den, b, h, dir) + (dir ? NC - 1 - n : n);
        bf16_t* st = ST + (size_t)slot * 4096 + (dvt * 32 + rr) * 64 + dkt2 * 32 + 4 * hh;
#pragma unroll
        for (int g4 = 0; g4 < 4; ++g4) { u32x2 w; w.x = cvt_pk_bf16(acc[4 * g4], acc[4 * g4 + 1]); w.y = cvt_pk_bf16(acc[4 * g4 + 2], acc[4 * g4 + 3]); *(u32x2*)(st + 8 * g4) = w; }
      }
    }
  }
  __syncthreads();
}
__device__ __forceinline__ void gla2(const Params& p, int layer, bf16_t* ST, const float* DEC) {
  const int tidx_ = otid(), bidx_ = obid(), gdim_ = ogdim(); (void)tidx_; (void)bidx_; (void)gdim_;
  const float* sg = p.in[I_SG];
  for (int it = bidx_; it < 512; it += gdim_) {
    const int e = (it & 7) * 512 + tidx_, dv = e >> 6, dk = e & 63;
    if (it < 256) {
      const int s2 = it >> 3; const int dir = s2 & 1, h = (s2 >> 1) & 3, b = s2 >> 3;
      const int slot0 = gla_slot(true, b, h, dir);
      float S = sg[(((((size_t)b * 4 + layer) * 2 + dir) * 4 + h) * 64 + dk) * 64 + dv];
#pragma unroll 1
      for (int n0 = 0; n0 < 64; n0 += 32) {
        float u[32], d[32];
#pragma unroll
        for (int j = 0; j < 32; ++j) { u[j] = bf2f(ST[(size_t)(slot0 + n0 + j) * 4096 + e]); d[j] = DEC[(size_t)(slot0 + n0 + j) * 64 + dk]; }
#pragma unroll
        for (int j = 0; j < 32; ++j) { ST[(size_t)(slot0 + n0 + j) * 4096 + e] = f2bf(S); S = d[j] * S + u[j]; }
      }
    } else {
      const int oct = (it - 256) >> 3;
      float u[8][4], d[8][4];
#pragma unroll
      for (int q = 0; q < 8; ++q) { const int slot0 = (oct * 8 + q) * 4;
#pragma unroll
        for (int j = 0; j < 4; ++j) { u[q][j] = bf2f(ST[(size_t)(slot0 + j) * 4096 + e]); d[q][j] = DEC[(size_t)(slot0 + j) * 64 + dk]; } }
#pragma unroll
      for (int q = 0; q < 8; ++q) { const int s2 = oct * 8 + q; const int dir = s2 & 1, h = (s2 >> 1) & 3, b = s2 >> 3; const int slot0 = s2 * 4;
        float S = 0.f;
#pragma unroll
        for (int j = 0; j < 4; ++j) { ST[(size_t)(slot0 + j) * 4096 + e] = f2bf(S); S = d[q][j] * S + u[q][j]; }
        p.out[OFF_ST + (((((size_t)b * 4 + layer) * 2 + dir) * 4 + h) * 64 + dk) * 64 + dv] = S; }
    }
  }
}
__device__ __forceinline__ void gla3(const Params& p, int layer, bf16_t* P, bf16_t* Y, const float* aFB, const bf16_t* ST, unsigned char* lds) {
  const int tidx_ = otid(), bidx_ = obid(), gdim_ = ogdim(); (void)tidx_; (void)bidx_; (void)gdim_;
  const int tid = tidx_, lane = tid & 63, wid = __builtin_amdgcn_readfirstlane(tid >> 6), rr = lane & 31, hh = lane >> 5;
  const int half = wid >> 2, lw = wid & 3, ltid = tid & 255;
  unsigned char* lb = lds + half * 65536;
  bf16_t* QD = (bf16_t*)lb;
  bf16_t* KI = (bf16_t*)(lb + 18432);
  bf16_t* VT = (bf16_t*)(lb + 36864);
  float* SS = (float*)(lb + 46080);
  float* SEG = (float*)(lb + 46592);
  const float* gn = p.in[I_GN] + layer * 64;
  for (int it2 = bidx_; it2 < 768; it2 += gdim_) {
    const int it = it2 * 2 + half;
    bool den; int b, h, n, NC;
    if (it < 1024) { den = true; NC = 64; n = it & 63; h = (it >> 6) & 3; b = it >> 8; }
    else { const int t2 = it - 1024; den = false; NC = 4; n = t2 & 3; h = (t2 >> 2) & 3; b = t2 >> 4; }
    const size_t rb = (den ? (size_t)NCTXR + (size_t)b * 4096 : (size_t)b * 256) + (size_t)n * 64;
    const int tt = lw & 1, dvt = lw >> 1;
    bf16x8 stf[2][4]; u32x2 gwv[4];
#pragma unroll
    for (int dir = 0; dir < 2; ++dir) { const int slot = gla_slot(den, b, h, dir) + (dir ? NC - 1 - n : n); const bf16_t* st = ST + (size_t)slot * 4096 + (dvt * 32 + rr) * 64 + hh * 8;
#pragma unroll
      for (int ks = 0; ks < 4; ++ks) stf[dir][ks] = ld_frag16(st + ks * 16); }
    { const size_t tok2 = rb + tt * 32 + rr;
#pragma unroll
      for (int g4 = 0; g4 < 4; ++g4) gwv[g4] = *(const u32x2*)(P + tok2 * NPW + PGD + h * 64 + dvt * 32 + 8 * g4 + 4 * hh); }
    const int dkt = dvt, dkc = dkt * 32 + rr;
    float qv[16], kv[16];
#pragma unroll
    for (int i = 0; i < 16; ++i) { const size_t tok = rb + tt * 32 + 16 * hh + i; qv[i] = bf2f(P[tok * NPW + PQD + h * 64 + dkc]); kv[i] = bf2f(P[tok * NPW + PKD + h * 64 + dkc]); }
    u32x4 vst[4];
    if (ltid < 128) {
#pragma unroll
      for (int i = 0; i < 4; ++i) vst[i] = *(const u32x4*)(P + (rb + 4 * (ltid >> 3) + i) * NPW + PVD + h * 64 + (ltid & 7) * 8);
    }
    __syncthreads();
    float G[2][16], tot[2];
    gla_decay(p, layer, h, rb, aFB, SEG, tt, dkt, rr, hh, G, tot);
#pragma unroll
    for (int dir = 0; dir < 2; ++dir)
#pragma unroll
      for (int i = 0; i < 16; ++i) { const int t = tt * 32 + 16 * hh + i;
        QD[dir * 4608 + t * 72 + dkc] = f2bf(qv[i] * __expf(G[dir][i])); KI[dir * 4608 + t * 72 + dkc] = f2bf(kv[i] * __expf(-G[dir][i])); }
    if (ltid < 128) {
      const int tq2 = ltid >> 3, part = ltid & 7;
#pragma unroll
      for (int e = 0; e < 8; ++e) { const int wi = e >> 1; const bool hi = e & 1; unsigned s[4];
#pragma unroll
        for (int i = 0; i < 4; ++i) s[i] = hi ? (vst[i][wi] >> 16) : (vst[i][wi] & 0xffffu);
        u32x2 w; w.x = s[0] | (s[1] << 16); w.y = s[2] | (s[3] << 16);
        *(u32x2*)(VT + (part * 8 + e) * 72 + 4 * tq2) = w; }
    }
    __syncthreads();
    f32x16 o = zero16();
#pragma unroll
    for (int dir = 0; dir < 2; ++dir) {
      bf16x8 qf[4];
#pragma unroll
      for (int ks = 0; ks < 4; ++ks) qf[ks] = ld_frag16(QD + dir * 4608 + (tt * 32 + rr) * 72 + ks * 16 + hh * 8);
#pragma unroll
      for (int st = 0; st < 2; ++st) {
        const bool use = dir ? (st >= tt) : (st <= tt);
        if (use) {
          f32x16 a = zero16();
#pragma unroll
          for (int ks = 0; ks < 4; ++ks) a = mfma32(ld_frag16(KI + dir * 4608 + (st * 32 + rr) * 72 + ks * 16 + hh * 8), qf[ks], a);
          const int t = tt * 32 + rr;
#pragma unroll
          for (int i = 0; i < 16; ++i) { const int s = st * 32 + (i & 3) + 8 * (i >> 2) + 4 * hh; const bool keep = dir ? (s >= t) : (s <= t); a[i] = keep ? a[i] : 0.f; }
#pragma unroll
          for (int sk = 0; sk < 2; ++sk) { const bf16_t* vp = VT + (dvt * 32 + rr) * 72 + st * 32 + 16 * sk + 4 * hh; o = mfma32(ld_frag8x2(vp, vp + 8), pack8(a, sk), o); }
        }
      }
#pragma unroll
      for (int ks = 0; ks < 4; ++ks) o = mfma32(stf[dir][ks], qf[ks], o);
    }
    float ss = 0.f;
#pragma unroll
    for (int i = 0; i < 16; ++i) ss += o[i] * o[i];
    ss += __shfl_xor(ss, 32);
    if (hh == 0) SS[dvt * 64 + tt * 32 + rr] = ss;
    __syncthreads();
    {
      const float tot = SS[tt * 32 + rr] + SS[64 + tt * 32 + rr];
      const float rstd = rsqrtf(tot * (1.f / 64.f) + 1e-6f);
      const size_t tok = rb + tt * 32 + rr;
#pragma unroll
      for (int g4 = 0; g4 < 4; ++g4) { const int dv = dvt * 32 + 8 * g4 + 4 * hh;
        const u32x2 gw = gwv[g4]; const f32x4 gg = *(const f32x4*)(gn + dv);
        u32x2 w; w.x = cvt_pk_bf16(o[4 * g4] * rstd * gg[0] * siluf(bflo(gw.x)), o[4 * g4 + 1] * rstd * gg[1] * siluf(bfhi(gw.x))); w.y = cvt_pk_bf16(o[4 * g4 + 2] * rstd * gg[2] * siluf(bflo(gw.y)), o[4 * g4 + 3] * rstd * gg[3] * siluf(bfhi(gw.y)));
        if (Y) *(u32x2*)(Y + tok * NPW + PVD + h * 64 + dv) = w; }
    }
  }
  __syncthreads();
}

#ifdef DBG
#define SEL4(k, a, b, c, d) ((k) == 0 ? (a) : (k) == 1 ? (b) : (k) == 2 ? (c) : (d))
constexpr size_t WS_DBG = WS_END;
__device__ __forceinline__ float bsum(float v, float* red, int tid) {
  __syncthreads(); red[tid] = v; __syncthreads();
  for (int s = 256; s > 0; s >>= 1) { if (tid < s) red[tid] += red[tid + s]; __syncthreads(); }
  const float r = red[0]; __syncthreads(); return r;
}
__device__ __forceinline__ float bmax(float v, float* red, int tid) {
  __syncthreads(); red[tid] = v; __syncthreads();
  for (int s = 256; s > 0; s >>= 1) { if (tid < s) red[tid] = fmaxf(red[tid], red[tid + s]); __syncthreads(); }
  const float r = red[0]; __syncthreads(); return r;
}
__device__ __forceinline__ void dbg_expect(const Params& p, const bf16_t* P, const float* aFB, float* dbg, unsigned char* lds) {
  const int tid = otid(); float* red = (float*)lds; float* Sm = (float*)(lds + 4096);
  const int i = obid(); if (i >= 28) return;
  const int cat = i >> 2, k = i & 3; float* ex = dbg + i * 64;
  const int layer = 0;
  if (cat == 0) {
    const int bs_ = SEL4(k, 0, 7, 19, 31), ss_ = SEL4(k, 0, 100, 255, 37), ds_ = SEL4(k, 0, 17, 63, 40);
    const int b = bs_, s = ss_, h = k, d = ds_; const size_t t = (size_t)b * 256 + s;
    float sc = -1e30f, vv = 0.f;
    if (tid < 256) { const size_t kt = (size_t)b * 256 + tid; float a = 0.f; for (int dd = 0; dd < 64; ++dd) a += bf2f(P[t * NPW + PQ + h * 64 + dd]) * bf2f(P[kt * NPW + PKA + h * 64 + dd]); sc = a; vv = bf2f(P[kt * NPW + PVA + h * 64 + d]); }
    const float m = bmax(sc, red, tid); const float pe = tid < 256 ? __expf(sc - m) : 0.f;
    const float l = bsum(pe, red, tid), o = bsum(pe * vv, red, tid);
    if (tid == 0) ex[0] = o / l * bf2f(P[t * NPW + PGA + h * 64 + d]);
  } else if (cat == 1) {
    const int rs4_ = SEL4(k, 0, 5, 63, 30), cs4_ = SEL4(k, 0, 63, 10, 33), ds_ = SEL4(k, 5, 60, 31, 0);
    const int b = k, r = rs4_, qc = cs4_, h = 3 - k, d = ds_; const size_t rb = (size_t)NCTXR + (size_t)b * 4096; const size_t t = rb + r * 64 + qc;
    const int rs = min(max(r - 4, 0), 56), cs = min(max(qc - 8, 0), 48);
    const int wi = tid >> 6, kc = tid & 63; const size_t kt = rb + (size_t)(rs + wi) * 64 + kc;
    float s1 = -1e30f, v1 = 0.f;
    if (kc >= cs && kc < cs + 16) { float a = 0.f; for (int dd = 0; dd < 64; ++dd) a += bf2f(P[t * NPW + PQ + h * 64 + dd]) * bf2f(P[kt * NPW + PKA + h * 64 + dd]);
      const int dr = rs + wi - r + 7, dc = min(max(kc - qc + 15, 0), 30); s1 = a + p.in[I_RPB][(((size_t)layer * 4 + h) * 15 + dr) * 31 + dc]; v1 = bf2f(P[kt * NPW + PVA + h * 64 + d]); }
    const size_t cb = ((((size_t)b * 4 + layer) * 4 + h) * 512 + tid) * 64;
    float s2 = 0.f; for (int dd = 0; dd < 64; ++dd) s2 += bf2f(P[t * NPW + PQ + h * 64 + dd]) * p.in[I_CK][cb + dd];
    const float v2 = p.in[I_CV][cb + d];
    const float m = bmax(fmaxf(s1, s2), red, tid); const float p1 = __expf(s1 - m), p2 = __expf(s2 - m);
    const float l = bsum(p1 + p2, red, tid), o = bsum(p1 * v1 + p2 * v2, red, tid);
    if (tid == 0) ex[0] = o / l * bf2f(P[t * NPW + PGA + h * 64 + d]);
  } else if (cat == 2 || cat == 3) {
    const bool den = cat == 3;
    const int bc_ = SEL4(k, 1, 30, 12, 5), kc4_ = SEL4(k, 0, 255, 77, 128), jc_ = SEL4(k, 0, 63, 21, 32), kd4_ = SEL4(k, 0, 4095, 1234, 2048), jd_ = SEL4(k, 1, 62, 33, 0);
    const int b = den ? k : bc_, kp = den ? kd4_ : kc4_, g = den ? 3 - k : k, j = den ? jd_ : jc_; const int S = den ? 4096 : 256;
    const size_t rb = den ? (size_t)NCTXR + (size_t)b * 4096 : (size_t)b * 256;
    float a = 0.f;
    for (int s = tid; s < S; s += NTHREADS) for (int c = 0; c < 64; ++c) { const float fr = (float)((kp * s) % S) / (float)S + (float)((j * c) & 63) / 64.f; a += bf2f(P[(rb + s) * NPW + PUC + g * 64 + c]) * cosf(6.283185307179586f * fr); }
    const float tot = bsum(a, red, tid);
    if (tid == 0) ex[0] = tot / sqrtf(64.f * S) * bf2f(P[(rb + kp) * NPW + PGC + g * 64 + j]);
    if (!den) { const int ka = kp & 3, s2 = (kp * 7 + 3) & 63; float tr = 0.f, ti = 0.f;
      if (tid < 256) { const int s1 = tid >> 6, c = tid & 63; const float ph = 6.283185307179586f * ((float)((ka * s1) & 3) * 0.25f + (float)((j * c) & 63) / 64.f + (float)((ka * s2) & 255) / 256.f);
        const float uu = bf2f(P[(rb + s1 * 64 + s2) * NPW + PUC + g * 64 + c]); tr = uu * cosf(ph); ti = -uu * sinf(ph); }
      const float sr = bsum(tr, red, tid), si = bsum(ti, red, tid);
      if (tid == 0) { ex[1] = sr / 128.f; ex[2] = si / 128.f; }
      for (int hyp = 1; hyp <= 6; ++hyp) { float hr = 0.f, hi2 = 0.f;
        if (tid < 256) { const int s1 = tid >> 6, c = tid & 63;
          float p1 = (float)((ka * s1) & 3) * 0.25f, p3 = (float)((ka * s2) & 255) / 256.f; const float p2 = (float)((j * c) & 63) / 64.f;
          if (hyp == 1) p3 = 0.f; if (hyp == 2 || hyp == 6) p1 = (float)((ka * s1) & 63) / 64.f; if (hyp == 3 || hyp == 6) p3 = (float)((ka * s2) & 4095) / 4096.f;
          const float ph = 6.283185307179586f * (p1 + p2 + p3); float uu = bf2f(P[(rb + s1 * 64 + s2) * NPW + PUC + g * 64 + c]);
          if (hyp == 4 && s1 > 0) uu = 0.f; if (hyp == 5) uu = 0.f;
          hr = uu * cosf(ph); hi2 = -uu * sinf(ph); }
        const float r1 = bsum(hr, red, tid), r2 = bsum(hi2, red, tid);
        if (tid == 0) { ex[2 * hyp + 1] = r1 / 128.f; ex[2 * hyp + 2] = r2 / 128.f; } } }
  } else if (cat == 4 || cat == 5) {
    const bool den = cat == 5;
    const int bc_ = SEL4(k, 2, 29, 15, 8), tc_ = SEL4(k, 0, 255, 64, 130), td_ = SEL4(k, 0, 4095, 63, 2100);
    const int b = den ? k : bc_, t = den ? td_ : tc_, h = den ? 3 - k : k; const int S = den ? 4096 : 256;
    const size_t rb = den ? (size_t)NCTXR + (size_t)b * 4096 : (size_t)b * 256;
    const int dk = tid >> 3, dv0 = (tid & 7) * 8;
    float osum = 0.f;
    for (int dir = 0; dir < 2; ++dir) {
      float St[8];
#pragma unroll
      for (int q = 0; q < 8; ++q) St[q] = den ? p.in[I_SG][(((((size_t)b * 4 + layer) * 2 + dir) * 4 + h) * 64 + dk) * 64 + dv0 + q] : 0.f;
      const float* up = p.in[dir ? I_UPB : I_UPF] + (size_t)layer * 16 * 256 + h * 64 + dk; const float bias = p.in[dir ? I_BB : I_BF][layer * 256 + h * 64 + dk];
      const int u0 = dir ? S - 1 : 0, du = dir ? -1 : 1; const int nsteps = dir ? S - t : t + 1;
      for (int st = 0; st < nsteps; ++st) { const int u = u0 + du * st; const size_t tok = rb + u;
        float z = bias; for (int q = 0; q < 16; ++q) z += aFB[tok * 32 + dir * 16 + q] * up[q * 256];
        const float a = __expf(logsigf(z) * (1.f / 16.f)); const float kk = bf2f(P[tok * NPW + PKD + h * 64 + dk]);
#pragma unroll
        for (int q = 0; q < 8; ++q) St[q] = a * St[q] + kk * bf2f(P[tok * NPW + PVD + h * 64 + dv0 + q]); }
      const float qq = bf2f(P[(rb + t) * NPW + PQD + h * 64 + dk]);
      __syncthreads();
#pragma unroll
      for (int q = 0; q < 8; ++q) Sm[dk * 64 + dv0 + q] = qq * St[q];
      __syncthreads();
      if (tid < 64) { float s = 0.f; for (int d2 = 0; d2 < 64; ++d2) s += Sm[d2 * 64 + tid]; osum += s; }
      __syncthreads();
    }
    float o = osum;
    const float ss = bsum(tid < 64 ? o * o : 0.f, red, tid);
    if (tid < 64) ex[tid] = o * rsqrtf(ss / 64.f + 1e-6f) * p.in[I_GN][layer * 64 + tid] * bf2f(P[(rb + t) * NPW + PGD + h * 64 + tid]);
  } else if (cat == 6) {
    const int rows_ = SEL4(k, 0, 255, 8192, 24575), chs_ = SEL4(k, 0, 100, 255, 7);
    const int row = rows_, ch = chs_; int s, S; if (row < NCTXR) { s = row & 255; S = 256; } else { s = (row - NCTXR) & 4095; S = 4096; }
    if (tid == 0) { float cv = 0.f; for (int d = 0; d < 3; ++d) { const int sd = s + d - 1; if (sd >= 0 && sd < S) { const size_t r2 = (size_t)row + d - 1; cv += bf2f(P[r2 * NPW + PCB + ch]) * bf2f(P[r2 * NPW + PHB + ch]) * p.in[I_CONV][layer * 768 + d * 256 + ch]; } }
      ex[0] = bf2f(P[(size_t)row * NPW + PBB + ch]) * cv * bf2f(P[(size_t)row * NPW + PGB + ch]); }
  }
}
__device__ __forceinline__ void dbg_compare(const bf16_t* P, float* dbg, const bf16_t* Zr, const bf16_t* Zi) {
  if (obid() != 0 || otid() != 0) return;
  int mask = 0, fine = 0, hypm = 0;
  for (int i = 0; i < 28; ++i) { const int cat = i >> 2, k = i & 3; const float* ex = dbg + i * 64; bool bad = false;
    if (cat == 0) { const int bs_ = SEL4(k, 0, 7, 19, 31), ss_ = SEL4(k, 0, 100, 255, 37), ds_ = SEL4(k, 0, 17, 63, 40); const size_t t = (size_t)bs_ * 256 + ss_;
      const float a = bf2f(P[t * NPW + PQ + k * 64 + ds_]); bad = !(fabsf(a - ex[0]) <= 0.01f + 0.03f * fabsf(ex[0])); }
    else if (cat == 1) { const int rs4_ = SEL4(k, 0, 5, 63, 30), cs4_ = SEL4(k, 0, 63, 10, 33), ds_ = SEL4(k, 5, 60, 31, 0); const size_t t = (size_t)NCTXR + (size_t)k * 4096 + rs4_ * 64 + cs4_;
      const float a = bf2f(P[t * NPW + PQ + (3 - k) * 64 + ds_]); bad = !(fabsf(a - ex[0]) <= 0.01f + 0.03f * fabsf(ex[0])); }
    else if (cat == 2) { const int bc_ = SEL4(k, 1, 30, 12, 5), kc4_ = SEL4(k, 0, 255, 77, 128), jc_ = SEL4(k, 0, 63, 21, 32); const size_t t = (size_t)bc_ * 256 + kc4_;
      const float a = bf2f(P[t * NPW + PUC + k * 64 + jc_]); bad = !(fabsf(a - ex[0]) <= 0.01f + 0.03f * fabsf(ex[0]));
      if (bad) fine |= (1 << k);
      const int ka = kc4_ & 3, s2 = (kc4_ * 7 + 3) & 63; const size_t zo = (((size_t)(bc_ * 4 + k) * 4 + ka) * 64 + jc_) * 64 + s2;
      const float zr = bf2f(Zr[zo]), zi = bf2f(Zi[zo]);
      if (k == 1) { for (int hyp = 1; hyp <= 6; ++hyp) if ((fabsf(zr - ex[2 * hyp + 1]) <= 0.01f + 0.03f * fabsf(ex[2 * hyp + 1])) && (fabsf(zi - ex[2 * hyp + 2]) <= 0.01f + 0.03f * fabsf(ex[2 * hyp + 2]))) hypm |= (1 << (hyp - 1)); } }
    else if (cat == 3) { const int kd4_ = SEL4(k, 0, 4095, 1234, 2048), jd_ = SEL4(k, 1, 62, 33, 0); const size_t t = (size_t)NCTXR + (size_t)k * 4096 + kd4_;
      const float a = bf2f(P[t * NPW + PUC + (3 - k) * 64 + jd_]); bad = !(fabsf(a - ex[0]) <= 0.01f + 0.03f * fabsf(ex[0])); }
    else if (cat == 4 || cat == 5) { const bool den = cat == 5; const int bc_ = SEL4(k, 2, 29, 15, 8), tc_ = SEL4(k, 0, 255, 64, 130), td_ = SEL4(k, 0, 4095, 63, 2100);
      const size_t t = den ? (size_t)NCTXR + (size_t)k * 4096 + td_ : (size_t)bc_ * 256 + tc_; const int h = den ? 3 - k : k;
      for (int d = 0; d < 64; ++d) { const float a = bf2f(P[t * NPW + PVD + h * 64 + d]); if (!(fabsf(a - ex[d]) <= 0.01f + 0.03f * fabsf(ex[d]))) bad = true; } }
    else { const int rows_ = SEL4(k, 0, 255, 8192, 24575), chs_ = SEL4(k, 0, 100, 255, 7);
      const float a = bf2f(P[(size_t)rows_ * NPW + PBB + chs_]); bad = !(fabsf(a - ex[0]) <= 0.01f + 0.03f * fabsf(ex[0])); }
    if (bad) mask |= (1 << cat);
  }
  dbg[32 * 64] = (float)((mask & 63) ? (mask & 63) : (mask >> 6) * 64); (void)fine; (void)hypm;
}
#endif
__global__ void __launch_bounds__(NTHREADS) fwd_megakernel(Params p) {
  const int tidx_ = otid(), bidx_ = obid(), gdim_ = ogdim(); (void)tidx_; (void)bidx_; (void)gdim_;
  extern __shared__ __attribute__((aligned(16))) unsigned char lds[];
  cg::grid_group grid = cg::this_grid();
  volatile LAS unsigned* bst = (volatile LAS unsigned*)((LAS unsigned char*)lds + (LDS_BYTES - 16));
  if (threadIdx.x == 0) { bst[0] = 0u; bst[1] = 0u; }
  __syncthreads();
  const XcdBarrier xb = xcd_barrier_post((unsigned*)(p.ws + WS_BAR), bst);
  unsigned char* ws = p.ws;
  bf16_t* P = (bf16_t*)(ws + WS_P); bf16_t* hN = (bf16_t*)(ws + WS_R);
  bf16_t* Zr = (bf16_t*)(ws + WS_R); bf16_t* Zi = (bf16_t*)(ws + WS_R + R_ZI); bf16_t* ST = (bf16_t*)(ws + WS_R + R_ST);
  bf16_t* WinT0 = (bf16_t*)(ws + WS_WIN); bf16_t* WaT0 = (bf16_t*)(ws + WS_WA); bf16_t* WoutT0 = (bf16_t*)(ws + WS_WOUT);
  float* mod = (float*)(ws + WS_MOD); float* aFB = (float*)(ws + WS_AFB); float* DEC = (float*)(ws + WS_DEC);
  LAS unsigned char* ldsl = (LAS unsigned char*)lds;
  bf16_t* DRY = nullptr; asm volatile("" : "+s"(DRY)); (void)DRY;

  phase_mod(p, (float*)(ws + WS_P), lds);
  phase_wconv(p, 0, WinT0, WaT0, WoutT0, lds, 0, gdim_);
  phase_cachecvt(p, (bf16_t*)(ws + WS_CKB), (bf16_t*)(ws + WS_CVB));
  if (p.ws == nullptr) grid.sync();
  xcd_barrier(xb);
  phase_mod_reduce(p, (const float*)(ws + WS_P), mod);
  xcd_barrier(xb);
  for (int layer = 0; layer < 4; ++layer) {
    const float* mod_l = mod + (size_t)layer * 5 * 3072;
    const int par = layer & 1;
    bf16_t* WinT = WinT0 + (size_t)par * NPW * DM; bf16_t* WaT = WaT0 + (size_t)par * 32 * DM; bf16_t* WoutT = WoutT0 + (size_t)par * DM * DM;
#if PROBE == 6
    phase_norm(p, layer, mod_l, hN, WinT, WaT, WoutT, lds);
#endif
    phase_norm(p, layer, mod_l, hN, WinT, WaT, WoutT, lds);
    xcd_barrier(xb);
    {
      pg8::Gemm g{hN, WinT, MROWS, NPW, DM, DM};
      pg8::StaticOrder S; S.init(MROWS, NPW, gdim_, bidx_);
      EpiIn E{P, p.in[I_QG] + layer * 64, p.in[I_KG] + layer * 64, p.out + OFF_CK, p.out + OFF_CV, layer};
#if PROBE == 5
      pg8::gemm_phase<EpiIn>(ldsl, g, S, E);
      phase_afb(hN, WaT, aFB);
#endif
      pg8::gemm_phase<EpiIn>(ldsl, g, S, E);
      phase_afb(hN, WaT, aFB);
    }
    xcd_barrier(xb);
#ifdef DBG
    if (layer == 0) { dbg_expect(p, P, aFB, (float*)(ws + WS_DBG), lds); __syncthreads(); }
#endif
#if PROBE == 1
    attn_den(p, layer, P, DRY, lds);
#endif
    attn_den(p, layer, P, P, lds);
#if PROBE == 8
    attn_ctx(P, DRY, lds); conv_mix(p, layer, P, DRY);
#endif
    attn_ctx(P, P, lds);
    conv_mix(p, layer, P, P);
#if PROBE == 3
    fourier1(P, Zr, Zi, lds);
#endif
    fourier1(P, Zr, Zi, lds);
#if PROBE == 4
    gla1(p, layer, P, aFB, ST, DEC, lds);
#endif
    gla1(p, layer, P, aFB, ST, DEC, lds);
    xcd_barrier(xb);
#if PROBE == 10
    fourier2(P, Zr, Zi, lds);
#endif
    fourier2(P, Zr, Zi, lds);
    gla2(p, layer, ST, DEC);
    xcd_barrier(xb);
#if PROBE == 2
    gla3(p, layer, P, DRY, aFB, ST, lds);
#endif
    gla3(p, layer, P, P, aFB, ST, lds);
    xcd_barrier(xb);
#if PROBE == 7
    for (int i = 0; i < 6; ++i) xcd_barrier(xb);
#endif
#ifdef DBG
    if (layer == 0) dbg_compare(P, (float*)(ws + WS_DBG), Zr, Zi);
#endif
    {
      pg8::Gemm g{P, WoutT, MROWS, DM, DM, NPW};
      pg8::StaticOrder S; S.init(MROWS, DM, gdim_, bidx_);
#if PROBE == 9
      { EpiOut E0{layer == 0 ? p.in[I_XP] : nullptr, p.in[I_XS], p.out, mod_l, (float*)DRY}; pg8::gemm_phase<EpiOut>(ldsl, g, S, E0); }
#endif
      EpiOut E{layer == 0 ? p.in[I_XP] : nullptr, p.in[I_XS], p.out, mod_l, p.out};
      pg8::gemm_phase<EpiOut>(ldsl, g, S, E);
      if (layer < 3) { const int np = par ^ 1; const int b0 = (gdim_ == 256) ? 128 : 0;
        phase_wconv(p, layer + 1, WinT0 + (size_t)np * NPW * DM, WaT0 + (size_t)np * 32 * DM, WoutT0 + (size_t)np * DM * DM, lds, b0, gdim_ - b0); }
    }
    xcd_barrier(xb);
  }
#ifdef DBG
  if (obid() == 0 && otid() == 0) p.out[0] += 10000.f * ((float*)(ws + WS_DBG))[32 * 64];
#endif
}

extern "C" void kernel_launch(void* const* d_in, const int* in_sizes, int n_in, void* d_out, int out_size,
                              void* d_ws, size_t ws_size, hipStream_t stream) {
  static int grid_blocks = 0;
  if (!grid_blocks) {
    int dev = 0, cus = 0;
    (void)hipGetDevice(&dev);
    (void)hipDeviceGetAttribute(&cus, hipDeviceAttributeMultiprocessorCount, dev);
    (void)hipFuncSetAttribute((const void*)fwd_megakernel, hipFuncAttributeMaxDynamicSharedMemorySize, LDS_BYTES);
    grid_blocks = cus > 0 ? cus : 256;
    if (ws_size < WS_END) fprintf(stderr, "workspace too small: %zu < %zu\n", ws_size, (size_t)WS_END);
  }
  (void)hipMemsetAsync((unsigned char*)d_ws + WS_BAR, 0, (size_t)XCD_BAR_WORDS * 4, stream);
  Params p{};
  for (int i = 0; i < 21; ++i) p.in[i] = (const float*)d_in[i];
  p.out = (float*)d_out;
  p.ws = (unsigned char*)d_ws;
  void* args[] = {&p};
  hipError_t e = hipLaunchCooperativeKernel((void*)fwd_megakernel, dim3(grid_blocks), dim3(NTHREADS), args, LDS_BYTES, stream);
  if (e != hipSuccess) fprintf(stderr, "cooperative launch failed: %s (grid %d)\n", hipGetErrorString(e), grid_blocks);
}
```

```cpp
#ifndef PROBE
#define PROBE 0
#endif
#include <hip/hip_runtime.h>
#include <hip/hip_cooperative_groups.h>
#include <cstdio>
#include <cstdint>
namespace cg = cooperative_groups;

#define LAS __attribute__((address_space(3)))
typedef unsigned short bf16_t;
typedef short bf16x8 __attribute__((ext_vector_type(8)));
typedef short bf16x4 __attribute__((ext_vector_type(4)));
typedef float f32x4 __attribute__((ext_vector_type(4)));
typedef float f32x16 __attribute__((ext_vector_type(16)));
typedef unsigned u32x4 __attribute__((ext_vector_type(4)));
typedef unsigned u32x2 __attribute__((ext_vector_type(2)));

constexpr int DM = 1024, NCTXR = 8192, NDENR = 16384, MROWS = 24576, NPW = 3584, NIN = 3616;
constexpr int NTHREADS = 512;
constexpr int LDS_BYTES = 147456;
constexpr int PQ = 0, PBB = 256, PUC = 512, PVD = 768, PKA = 1024, PVA = 1280, PGA = 1536, PCB = 1792, PHB = 2048, PGB = 2304, PGC = 2560, PQD = 2816, PKD = 3072, PGD = 3328;
constexpr long long OFF_YP = 0, OFF_CK = 25165824LL, OFF_CV = 33554432LL, OFF_ST = 41943040LL;
constexpr size_t WS_P = 0;
constexpr size_t WS_R = WS_P + (size_t)MROWS * NPW * 2;
constexpr size_t WS_WIN = WS_R + (size_t)MROWS * DM * 2;
constexpr size_t WS_WA = WS_WIN + (size_t)2 * NPW * DM * 2;
constexpr size_t WS_WOUT = WS_WA + (size_t)2 * 32 * DM * 2;
constexpr size_t WS_MOD = WS_WOUT + (size_t)2 * DM * DM * 2;
constexpr size_t WS_AFB = WS_MOD + (size_t)4 * 5 * 3072 * 4;
constexpr size_t WS_DEC = WS_AFB + (size_t)MROWS * 32 * 4;
constexpr size_t WS_CKB = WS_DEC + (size_t)3072 * 64 * 4;
constexpr size_t WS_CVB = WS_CKB + (size_t)2097152 * 2;
constexpr size_t WS_BAR = WS_CVB + (size_t)2097152 * 2;
constexpr size_t WS_END = WS_BAR + (size_t)16384;
constexpr size_t R_ZI = 12582912, R_ST = 25165824;

struct Params {
  const float* in[21];
  float* out;
  unsigned char* ws;
};
enum { I_XP = 0, I_XS, I_CK, I_CV, I_SG, I_C, I_CCTX, I_NG, I_WMOD, I_BMOD, I_WIN, I_QG, I_KG, I_RPB, I_CONV, I_UPF, I_BF, I_UPB, I_BB, I_GN, I_WOUT };

typedef __bf16 bf16v2_t __attribute__((ext_vector_type(2)));
typedef float f32v2_t __attribute__((ext_vector_type(2)));
__device__ __forceinline__ unsigned cvt_pk_bf16(float lo, float hi) { f32v2_t v = {lo, hi}; bf16v2_t b = __builtin_convertvector(v, bf16v2_t); return __builtin_bit_cast(unsigned, b); }
__device__ __forceinline__ float bf2f(unsigned short h) { return __uint_as_float(((unsigned)h) << 16); }
__device__ __forceinline__ float bflo(unsigned w) { return __uint_as_float(w << 16); }
__device__ __forceinline__ float bfhi(unsigned w) { return __uint_as_float(w & 0xffff0000u); }
__device__ __forceinline__ unsigned short f2bf(float f) { return (unsigned short)(cvt_pk_bf16(f, 0.f) & 0xffffu); }
__device__ __forceinline__ float siluf(float x) { return x / (1.f + __expf(-x)); }
__device__ __forceinline__ float logsigf(float z) { return fminf(z, 0.f) - __logf(1.f + __expf(-fabsf(z))); }
__device__ __forceinline__ bf16x8 as_bf16x8(u32x4 v) { return __builtin_bit_cast(bf16x8, v); }
__device__ __forceinline__ f32x16 mfma32(bf16x8 a, bf16x8 b, f32x16 c) { return __builtin_amdgcn_mfma_f32_32x32x16_bf16(a, b, c, 0, 0, 0); }
__device__ __forceinline__ f32x16 zero16() { f32x16 z;
#pragma unroll
  for (int i = 0; i < 16; ++i) z[i] = 0.f; return z; }
__device__ __forceinline__ bf16x8 pack8(const f32x16& a, int s) {
  u32x4 w; w.x = cvt_pk_bf16(a[8 * s + 0], a[8 * s + 1]); w.y = cvt_pk_bf16(a[8 * s + 2], a[8 * s + 3]); w.z = cvt_pk_bf16(a[8 * s + 4], a[8 * s + 5]); w.w = cvt_pk_bf16(a[8 * s + 6], a[8 * s + 7]);
  return as_bf16x8(w);
}
__device__ __forceinline__ bf16x8 ld_frag16(const void* p) { return as_bf16x8(*(const u32x4*)p); }
__device__ __forceinline__ bf16x8 ld_frag8x2(const void* lo, const void* hi) { u32x2 a = *(const u32x2*)lo, b = *(const u32x2*)hi; u32x4 w; w.x = a.x; w.y = a.y; w.z = b.x; w.w = b.y; return as_bf16x8(w); }
__device__ __forceinline__ bf16x8 ld_f32x8_as_bf16(const float* p) { f32x4 a = *(const f32x4*)p, b = *(const f32x4*)(p + 4); u32x4 w; w.x = cvt_pk_bf16(a[0], a[1]); w.y = cvt_pk_bf16(a[2], a[3]); w.z = cvt_pk_bf16(b[0], b[1]); w.w = cvt_pk_bf16(b[2], b[3]); return as_bf16x8(w); }

__device__ __forceinline__ int row_vec(int row) { return row < NCTXR ? 0 : 1 + ((row - NCTXR) >> 12); }

__device__ __forceinline__ int otid() { int t = threadIdx.x; asm volatile("" : "+v"(t)); return t; }
__device__ __forceinline__ int obid() { int t = blockIdx.x; asm volatile("" : "+s"(t)); return t; }
__device__ __forceinline__ int ogdim() { int t = gridDim.x; asm volatile("" : "+s"(t)); return t; }


#define XB_TMO      128
#define XB_XCNT(j)  (256  + 64 * (j))
#define XB_XSUB(j)  (1280 + 64 * (j))
#define XB_XGEN(j)  (2304 + 64 * (j))
#define XB_TOP      3328
#define XB_TOPGEN   3392
#define XCD_BAR_WORDS 3456
#define XB_SPIN_CAP (1u << 18)
__device__ __forceinline__ unsigned xb_ld(unsigned* p)              { return __hip_atomic_load(p, __ATOMIC_RELAXED, __HIP_MEMORY_SCOPE_AGENT); }
__device__ __forceinline__ unsigned xb_add(unsigned* p, unsigned v) { return __hip_atomic_fetch_add(p, v, __ATOMIC_RELAXED, __HIP_MEMORY_SCOPE_AGENT); }
__device__ __forceinline__ unsigned xb_xcc_id() { return (unsigned)__builtin_amdgcn_s_getreg((3 << 11) | 20) & 0xFu; }
#define XB_SPIN(cond, bar) do { unsigned _sp = 0; while (cond) { __builtin_amdgcn_s_sleep(1); \
    if ((++_sp & 255u) == 0u) { if (xb_ld(&(bar)[XB_TMO])) break; if (_sp > XB_SPIN_CAP) { atomicAdd(&(bar)[XB_TMO], 1u); break; } } } } while (0)
struct XcdBarrier { unsigned* bar; unsigned x; volatile LAS unsigned* st; };
__device__ __forceinline__ XcdBarrier xcd_barrier_post(unsigned* bar, volatile LAS unsigned* st) {
  XcdBarrier b; b.bar = bar; b.x = xb_xcc_id(); b.st = st;
  if (threadIdx.x == 0) (void)xb_add(&bar[XB_XCNT(b.x)], 1u);
  return b;
}
__device__ __forceinline__ void xcd_barrier_complete(unsigned* bar, unsigned x, unsigned& nloc, unsigned& nx) {
  const unsigned G = gridDim.x * gridDim.y * gridDim.z;
  unsigned sum, cnt, mine, sp = 0u;
  for (;;) {
    sum = 0u; cnt = 0u; mine = 0u;
#pragma unroll
    for (unsigned j = 0; j < 16; ++j) { const unsigned c = xb_ld(&bar[XB_XCNT(j)]); sum += c; cnt += (c > 0u) ? 1u : 0u; mine = (j == x) ? c : mine; }
    if (sum == G) break;
    __builtin_amdgcn_s_sleep(1);
    if ((++sp & 255u) == 0u) { if (xb_ld(&bar[XB_TMO])) break; if (sp > XB_SPIN_CAP) { atomicAdd(&bar[XB_TMO], 1u); break; } }
  }
  nloc = mine > 0u ? mine : 1u; nx = cnt > 0u ? cnt : 1u;
}
__device__ __forceinline__ void xcd_barrier(const XcdBarrier& b) {
  asm volatile("s_waitcnt vmcnt(0)" ::: "memory");
  __syncthreads();
  if (threadIdx.x == 0) {
    unsigned* bar = b.bar;
    __builtin_amdgcn_s_waitcnt(0);
    unsigned nloc = b.st[0], nx = b.st[1];
    if (nloc == 0u) { xcd_barrier_complete(bar, b.x, nloc, nx); b.st[0] = nloc; b.st[1] = nx; }
    const unsigned old = xb_add(&bar[XB_XSUB(b.x)], 1u);
    const unsigned gen = old / nloc;
    if (old + 1u == (gen + 1u) * nloc) {
      __builtin_amdgcn_fence(__ATOMIC_RELEASE, "agent");
      asm volatile("s_waitcnt vmcnt(0)" ::: "memory");
      const unsigned og = xb_add(&bar[XB_TOP], 1u);
      const unsigned tg = og / nx;
      if (og + 1u == (tg + 1u) * nx) xb_add(&bar[XB_TOPGEN], 1u);
      else XB_SPIN(xb_ld(&bar[XB_TOPGEN]) == tg, bar);
      __builtin_amdgcn_fence(__ATOMIC_ACQUIRE, "agent");
      xb_add(&bar[XB_XGEN(b.x)], 1u);
      asm volatile("s_waitcnt vmcnt(0)" ::: "memory");
    } else {
      XB_SPIN(xb_ld(&bar[XB_XGEN(b.x)]) == gen, bar);
      __builtin_amdgcn_fence(__ATOMIC_ACQUIRE, "agent");
      asm volatile("s_waitcnt vmcnt(0)" ::: "memory");
    }
  }
  __syncthreads();
}

namespace pg8 {
constexpr int BM = 256, BK = 64, HALF = 128, HTB = HALF * BK * 2, NXCD = 8, WGM = 8;
__host__ __device__ __forceinline__ int lds_byte(int r, int c) { const int st = (r >> 4) * 2 + (c >> 5), rr = r & 15, cc = c & 31, ob = rr * 64 + cc * 2; return st * 1024 + (ob ^ (((ob >> 9) & 1) << 5)); }
__host__ __device__ __forceinline__ void stage_rc(int b, int& R, int& C) { const int st = b / 1024, sb = b % 1024, swz = sb ^ (((sb >> 9) & 1) << 5); R = (st >> 1) * 16 + swz / 64; C = (st & 1) * 32 + (swz % 64) / 2; }
struct Unit { int pm, pn; };
struct Gemm { const bf16_t* A; const bf16_t* Bt; int M, N, K, lda; };
struct StaticOrder {
  int nM, nN, nwg, G, c;
  __device__ void init(int M, int N, int G_, int c_) { nM = M / BM; nN = N / BM; nwg = nM * nN; G = G_; c = c_; }
  __device__ bool next(int i, Unit& u) const {
    const long L = (long)i * G + c; if (L >= nwg) return false;
    int wgid = (int)L; { const int q = nwg / NXCD, r = nwg % NXCD, xcd = wgid % NXCD, off = wgid / NXCD; wgid = (xcd < r ? xcd * (q + 1) : r * (q + 1) + (xcd - r) * q) + off; }
    const int nig = WGM * nN, gid = wgid / nig, fm = gid * WGM, gsz = (nM - fm) < WGM ? (nM - fm) : WGM;
    u.pm = fm + ((wgid % nig) % gsz); u.pn = (wgid % nig) / gsz; return true;
  }
};
template <class Epi>
__device__ __forceinline__ void gemm_phase(LAS unsigned char* lds, const Gemm g, const StaticOrder& S, const Epi& E) {
  const int tidx_ = otid(), bidx_ = obid(), gdim_ = ogdim(); (void)tidx_; (void)bidx_; (void)gdim_;
  const int tid = tidx_, wid = __builtin_amdgcn_readfirstlane(tid >> 6), lane = tid & 63, wr = wid >> 2, wc = wid & 3, fr = lane & 15, fq = lane >> 4;
  const int K = g.K, nt = K / BK, lda = g.lda;
  unsigned voffA[2], voffB[2];
#pragma unroll
  for (int i = 0; i < 2; ++i) { int R, C; stage_rc(tid * 16 + i * 8192, R, C); voffA[i] = (unsigned)(R * lda + C) * 2u; voffB[i] = (unsigned)(R * K + C) * 2u; }
  const size_t kstep = (size_t)(BK * 2);
  const size_t hstepA = (size_t)HALF * lda * 2, hstepB = (size_t)HALF * K * 2;
  const size_t tstepA = 2 * hstepA, tstepB = 2 * hstepB;
  const unsigned ldsw = (unsigned)wid * 1024u;
  const int aoff = lds_byte(wr * 64 + fr, fq * 8), boff = lds_byte(wc * 32 + fr, fq * 8);
#define PG8_SA(b, h) (((b) * 2 + (h)) * HTB)
#define PG8_SB(b, h) ((4 + (b) * 2 + (h)) * HTB)
#define PG8_STAGE(bufoff, gbase, voff) do { _Pragma("unroll") for (int _i = 0; _i < 2; ++_i) \
    __builtin_amdgcn_global_load_lds((const unsigned*)((const char*)(gbase) + (voff)[_i]), (LAS unsigned*)(lds + (bufoff) + ldsw + _i * 8192), 16, 0, 0); } while (0)
#define PG8_LDA(dst, b, h) do { _Pragma("unroll") for (int m = 0; m < 4; ++m) _Pragma("unroll") for (int k = 0; k < 2; ++k) dst[m][k] = *(const LAS bf16x8*)(lds + PG8_SA(b, h) + aoff + m * 2048 + k * 1024); } while (0)
#define PG8_LDB(dst, b, h) do { _Pragma("unroll") for (int n = 0; n < 2; ++n) _Pragma("unroll") for (int k = 0; k < 2; ++k) dst[n][k] = *(const LAS bf16x8*)(lds + PG8_SB(b, h) + boff + n * 2048 + k * 1024); } while (0)
#define PG8_MMA(ai, bj, At, Bt) do { __builtin_amdgcn_s_setprio(1); _Pragma("unroll") for (int m = 0; m < 4; ++m) _Pragma("unroll") for (int n = 0; n < 2; ++n) _Pragma("unroll") for (int k = 0; k < 2; ++k) \
    acc[ai][bj][m][n] = __builtin_amdgcn_mfma_f32_16x16x32_bf16(Bt[n][k], At[m][k], acc[ai][bj][m][n], 0, 0, 0); __builtin_amdgcn_s_setprio(0); } while (0)
#define PG8_WAIT_V(n) asm volatile("s_waitcnt vmcnt(" #n ")" ::: "memory")
#define PG8_WAIT_L(n) asm volatile("s_waitcnt lgkmcnt(" #n ")" ::: "memory")
#define PG8_BAR __builtin_amdgcn_s_barrier()
#define PG8_SCHED __builtin_amdgcn_sched_barrier(0)
  Unit cur, nxt; int ui = 0;
  if (!S.next(0, cur)) return;
  f32x4 acc[2][2][4][2];
#pragma unroll
  for (int a = 0; a < 2; ++a)
#pragma unroll
    for (int b = 0; b < 2; ++b)
#pragma unroll
      for (int m = 0; m < 4; ++m)
#pragma unroll
        for (int n = 0; n < 2; ++n) acc[a][b][m][n] = (f32x4){0.f, 0.f, 0.f, 0.f};
  bf16x8 At[4][2], B0[2][2], B1[2][2];
  const char* cA = (const char*)g.A + (size_t)cur.pm * tstepA; const char* cB = (const char*)g.Bt + (size_t)cur.pn * tstepB;
  PG8_STAGE(PG8_SB(0, 0), cB, voffB); PG8_STAGE(PG8_SB(0, 1), cB + hstepB, voffB); PG8_STAGE(PG8_SA(0, 0), cA, voffA); PG8_STAGE(PG8_SA(0, 1), cA + hstepA, voffA);
  if (wr == 1) PG8_BAR;
  PG8_WAIT_V(2); PG8_BAR;
  PG8_STAGE(PG8_SB(1, 0), cB + kstep, voffB); PG8_STAGE(PG8_SA(1, 0), cA + kstep, voffA); PG8_STAGE(PG8_SB(1, 1), cB + hstepB + kstep, voffB);
  PG8_WAIT_V(6); PG8_BAR;
  for (;;) {
    const bool has_next = S.next(ui + 1, nxt);
    const char* nA = has_next ? (const char*)g.A + (size_t)nxt.pm * tstepA : cA; const char* nB = has_next ? (const char*)g.Bt + (size_t)nxt.pn * tstepB : cB;
    for (int t = 0; t < nt; t += 2) {
      const bool last = (t == nt - 2);
      const char* a1 = cA + (size_t)(t + 1) * kstep;
      const char* a2 = last ? nA : cA + (size_t)(t + 2) * kstep; const char* b2 = last ? nB : cB + (size_t)(t + 2) * kstep;
      const char* a3 = a2 + kstep; const char* b3 = b2 + kstep;
      PG8_LDB(B0, 0, 0); PG8_LDB(B1, 0, 1); PG8_SCHED; PG8_LDA(At, 0, 0); PG8_STAGE(PG8_SA(1, 1), a1 + hstepA, voffA);
      PG8_WAIT_V(8); PG8_WAIT_L(0); PG8_BAR; PG8_MMA(0, 0, At, B0); PG8_MMA(0, 1, At, B1); PG8_BAR; PG8_SCHED;
      PG8_LDA(At, 0, 1); PG8_STAGE(PG8_SB(0, 0), b2, voffB); PG8_STAGE(PG8_SB(0, 1), b2 + hstepB, voffB); PG8_STAGE(PG8_SA(0, 0), a2, voffA);
      PG8_WAIT_V(8); PG8_WAIT_L(0); PG8_BAR; PG8_MMA(1, 0, At, B0); PG8_MMA(1, 1, At, B1); PG8_BAR; PG8_SCHED;
      PG8_LDB(B0, 1, 0); PG8_LDB(B1, 1, 1); PG8_SCHED; PG8_LDA(At, 1, 0); PG8_STAGE(PG8_SA(0, 1), a2 + hstepA, voffA);
      PG8_WAIT_V(8); PG8_WAIT_L(0); PG8_BAR; PG8_MMA(0, 0, At, B0); PG8_MMA(0, 1, At, B1); PG8_BAR; PG8_SCHED;
      PG8_LDA(At, 1, 1); PG8_STAGE(PG8_SB(1, 0), b3, voffB); PG8_STAGE(PG8_SB(1, 1), b3 + hstepB, voffB); PG8_STAGE(PG8_SA(1, 0), a3, voffA);
      PG8_WAIT_V(8); PG8_WAIT_L(0); PG8_BAR; PG8_MMA(1, 0, At, B0); PG8_MMA(1, 1, At, B1); PG8_BAR; PG8_SCHED;
    }
    if (wr == 0) PG8_BAR;
    E(acc, cur, wr, wc, fr, fq);
    if (!has_next) break;
#pragma unroll
    for (int a = 0; a < 2; ++a)
#pragma unroll
      for (int b = 0; b < 2; ++b)
#pragma unroll
        for (int m = 0; m < 4; ++m)
#pragma unroll
          for (int n = 0; n < 2; ++n) acc[a][b][m][n] = (f32x4){0.f, 0.f, 0.f, 0.f};
    cur = nxt; cA = nA; cB = nB; ++ui;
    if (wr == 1) PG8_BAR;
  }
  PG8_WAIT_V(0);
  PG8_BAR;
#undef PG8_SA
#undef PG8_SB
#undef PG8_STAGE
#undef PG8_LDA
#undef PG8_LDB
#undef PG8_MMA
#undef PG8_WAIT_V
#undef PG8_WAIT_L
#undef PG8_BAR
#undef PG8_SCHED
}
}

struct EpiIn {
  bf16_t* P; const float* qg; const float* kg; float* ck; float* cv; int layer;
  __device__ __forceinline__ void operator()(const f32x4 (&acc)[2][2][4][2], const pg8::Unit& u, int wr, int wc, int fr, int fq) const {
    const int gp = u.pn;
    const int row0 = u.pm * 256 + wr * 64 + fr;
    const int cl = wc * 64 + 8 * fq;
    const bool isq = (gp == 0), isk = (gp == 4), isv = (gp == 5), isqd = (gp == 11);
    const bool ctxrow = u.pm < 32;
#pragma unroll
    for (int ai = 0; ai < 2; ++ai)
#pragma unroll
      for (int m = 0; m < 4; ++m) {
        const int row = row0 + ai * 128 + m * 16;
        float sc = 1.f;
        if (isq || isk) {
          float ss = 0.f;
#pragma unroll
          for (int bj = 0; bj < 2; ++bj)
#pragma unroll
            for (int n = 0; n < 2; ++n) { const f32x4 x = acc[ai][bj][m][n]; ss += (x[0] * x[0] + x[1] * x[1]) + (x[2] * x[2] + x[3] * x[3]); }
          ss += __shfl_xor(ss, 16); ss += __shfl_xor(ss, 32);
          sc = rsqrtf(ss * (1.f / 64.f) + 1e-6f);
          if (isq) sc *= 0.125f;
        }
        if (isqd) sc = 0.125f;
#pragma unroll
        for (int bj = 0; bj < 2; ++bj) {
          f32x4 v0 = acc[ai][bj][m][0] * sc, v1 = acc[ai][bj][m][1] * sc;
          const int c = cl + 32 * bj;
          if (isq || isk) {
            const float* gg = (isq ? qg : kg) + (c & 63);
            const f32x4 g0 = *(const f32x4*)gg, g1 = *(const f32x4*)(gg + 4);
            v0 = v0 * g0; v1 = v1 * g1;
          }
          u32x4 w; w.x = cvt_pk_bf16(v0[0], v0[1]); w.y = cvt_pk_bf16(v0[2], v0[3]); w.z = cvt_pk_bf16(v1[0], v1[1]); w.w = cvt_pk_bf16(v1[2], v1[3]);
          *(u32x4*)(P + (size_t)row * NPW + gp * 256 + c) = w;
          if ((isk || isv) && ctxrow) {
            const int b = row >> 8, s = row & 255, h = c >> 6, d = c & 63;
            float* o = (isk ? ck : cv) + ((((size_t)b * 4 + layer) * 4 + h) * 256 + s) * 64 + d;
            *(f32x4*)o = v0; *(f32x4*)(o + 4) = v1;
          }
        }
      }
  }
};
struct EpiOut {
  const float* xp; const float* xs; float* out; const float* mod; float* dst;
  __device__ __forceinline__ void operator()(const f32x4 (&acc)[2][2][4][2], const pg8::Unit& u, int wr, int wc, int fr, int fq) const {
    const int row0 = u.pm * 256 + wr * 64 + fr;
    const int c0 = u.pn * 256 + wc * 64 + 8 * fq;
    const float* gv = mod + (size_t)row_vec(u.pm * 256) * 3072 + 2048;
    const float* src = xp ? (u.pm < 32 ? xp : xs - (size_t)NCTXR * DM) : out;
#pragma unroll
    for (int bj = 0; bj < 2; ++bj) {
      const int c = c0 + 32 * bj;
      const f32x4 g0 = *(const f32x4*)(gv + c), g1 = *(const f32x4*)(gv + c + 4);
#pragma unroll
      for (int ai = 0; ai < 2; ++ai)
#pragma unroll
        for (int m = 0; m < 4; ++m) {
          const size_t off = (size_t)(row0 + ai * 128 + m * 16) * DM + c;
          const f32x4 x0 = *(const f32x4*)(src + off), x1 = *(const f32x4*)(src + off + 4);
          if (dst) { *(f32x4*)(dst + off) = x0 + g0 * acc[ai][bj][m][0];
            *(f32x4*)(dst + off + 4) = x1 + g1 * acc[ai][bj][m][1]; }
        }
    }
  }
};

__device__ __forceinline__ void phase_mod(const Params& p, float* part, unsigned char* lds) {
  const int tidx_ = otid(), bidx_ = obid(), gdim_ = ogdim(); (void)tidx_; (void)bidx_; (void)gdim_;
  const float* wmod = p.in[I_WMOD]; const float* c = p.in[I_C]; const float* cctx = p.in[I_CCTX];
  float* sl = (float*)lds;
  for (int it = bidx_; it < 4 * 6 * 16; it += gdim_) {
    const int l = it / 96, cb = (it % 96) / 16, ks = it % 16;
    const int col = cb * 512 + tidx_;
    __syncthreads();
    if (tidx_ < 320) { const int v = tidx_ >> 6, k = ks * 64 + (tidx_ & 63); sl[tidx_] = siluf(v == 0 ? cctx[k] : c[(v - 1) * DM + k]); }
    __syncthreads();
    float a[5] = {0.f, 0.f, 0.f, 0.f, 0.f};
    const float* wp = wmod + ((size_t)l * DM + ks * 64) * 3072 + col;
#pragma unroll 1
    for (int k0 = 0; k0 < 64; k0 += 16) {
      float w[16];
#pragma unroll
      for (int j = 0; j < 16; ++j) w[j] = wp[(size_t)(k0 + j) * 3072];
#pragma unroll
      for (int j = 0; j < 16; ++j)
#pragma unroll
        for (int v = 0; v < 5; ++v) a[v] += sl[v * 64 + k0 + j] * w[j];
    }
#pragma unroll
    for (int v = 0; v < 5; ++v) part[((size_t)ks * 20 + l * 5 + v) * 3072 + col] = a[v];
  }
  __syncthreads();
}
__device__ __forceinline__ void phase_mod_reduce(const Params& p, const float* part, float* mod) {
  const int tidx_ = otid(), bidx_ = obid(), gdim_ = ogdim(); (void)tidx_; (void)bidx_; (void)gdim_;
  const float* bmod = p.in[I_BMOD];
  for (int e = bidx_ * NTHREADS + tidx_; e < 20 * 3072; e += gdim_ * NTHREADS) {
    const int lv = e / 3072, col = e % 3072, l = lv / 5;
    float s = bmod[l * 3072 + col];
#pragma unroll
    for (int ks = 0; ks < 16; ++ks) s += part[((size_t)ks * 20 + lv) * 3072 + col];
    mod[e] = s;
  }
}

__device__ __forceinline__ void phase_norm(const Params& p, int layer, const float* mod_l, bf16_t* hN, bf16_t* WinT, bf16_t* WaT, bf16_t* WoutT, unsigned char* lds) {
  const int tidx_ = otid(), bidx_ = obid(), gdim_ = ogdim(); (void)tidx_; (void)bidx_; (void)gdim_;
  const int tid = tidx_, lane = tid & 63, wid = __builtin_amdgcn_readfirstlane(tid >> 6);
  const float* ng = p.in[I_NG] + layer * DM;
  const int rstep = gdim_ * 8;
  int row = bidx_ * 8 + wid;
  f32x4 vn[4];
  if (row < MROWS) { const float* x = (layer == 0) ? (row < NCTXR ? p.in[I_XP] + (size_t)row * DM : p.in[I_XS] + (size_t)(row - NCTXR) * DM) : p.out + (size_t)row * DM;
#pragma unroll
    for (int i = 0; i < 4; ++i) vn[i] = *(const f32x4*)(x + i * 256 + lane * 4); }
  for (; row < MROWS; row += rstep) {
    f32x4 v[4];
#pragma unroll
    for (int i = 0; i < 4; ++i) v[i] = vn[i];
    const int nrow = row + rstep;
    if (nrow < MROWS) { const float* x = (layer == 0) ? (nrow < NCTXR ? p.in[I_XP] + (size_t)nrow * DM : p.in[I_XS] + (size_t)(nrow - NCTXR) * DM) : p.out + (size_t)nrow * DM;
#pragma unroll
      for (int i = 0; i < 4; ++i) vn[i] = *(const f32x4*)(x + i * 256 + lane * 4); }
    const float* mv = mod_l + (size_t)row_vec(row) * 3072;
    float ss = 0.f;
#pragma unroll
    for (int i = 0; i < 4; ++i) ss += (v[i][0] * v[i][0] + v[i][1] * v[i][1]) + (v[i][2] * v[i][2] + v[i][3] * v[i][3]);
#pragma unroll
    for (int o = 1; o < 64; o <<= 1) ss += __shfl_xor(ss, o);
    const float rstd = rsqrtf(ss * (1.f / 1024.f) + 1e-6f);
#pragma unroll
    for (int i = 0; i < 4; ++i) {
      const int c = i * 256 + lane * 4;
      const f32x4 g = *(const f32x4*)(ng + c), sh = *(const f32x4*)(mv + c), scl = *(const f32x4*)(mv + 1024 + c);
      f32x4 y;
#pragma unroll
      for (int j = 0; j < 4; ++j) y[j] = v[i][j] * rstd * g[j] * (1.f + scl[j]) + sh[j];
      u32x2 w; w.x = cvt_pk_bf16(y[0], y[1]); w.y = cvt_pk_bf16(y[2], y[3]);
      *(u32x2*)(hN + (size_t)row * DM + c) = w;
    }
  }
}

__device__ __forceinline__ void phase_wconv(const Params& p, int layer, bf16_t* WinT, bf16_t* WaT, bf16_t* WoutT, unsigned char* lds, int b0, int nb) {
  const int tidx_ = otid(), bidx_ = obid(), gdim_ = ogdim(); (void)tidx_; (void)bidx_; (void)gdim_;
  const int tid = tidx_;
  if (bidx_ < b0 || bidx_ >= b0 + nb) return;
  float* tile = (float*)lds;
  const float* win = p.in[I_WIN] + (size_t)layer * DM * NIN; const float* wout = p.in[I_WOUT] + (size_t)layer * DM * DM;
  const int NT_IN = 16 * 57, NT_ALL = NT_IN + 16 * 16;
  for (int it = bidx_ - b0; it < NT_ALL; it += nb) {
    const bool isin = it < NT_IN; const int t2 = isin ? it : it - NT_IN;
    const int kt = t2 & 15, ntile = t2 >> 4; const int ncols = isin ? NIN : DM; const float* W = isin ? win : wout;
    __syncthreads();
    float wv[8];
#pragma unroll
    for (int i = 0; i < 8; ++i) { const int e = tid + i * 512, kk = e >> 6, nn = e & 63; const int n = ntile * 64 + nn; wv[i] = W[(size_t)(kt * 64 + kk) * ncols + min(n, ncols - 1)]; }
#pragma unroll
    for (int i = 0; i < 8; ++i) { const int e = tid + i * 512, kk = e >> 6, nn = e & 63; const int n = ntile * 64 + nn; tile[kk * 65 + nn] = (n < ncols) ? wv[i] : 0.f; }
    __syncthreads();
    const int nn = tid >> 3, kseg = tid & 7, nl = ntile * 64 + nn;
    if (nl < ncols) {
      u32x4 w; float f[8];
#pragma unroll
      for (int j = 0; j < 8; ++j) f[j] = tile[(kseg * 8 + j) * 65 + nn];
      w.x = cvt_pk_bf16(f[0], f[1]); w.y = cvt_pk_bf16(f[2], f[3]); w.z = cvt_pk_bf16(f[4], f[5]); w.w = cvt_pk_bf16(f[6], f[7]);
      bf16_t* dst;
      if (isin && nl >= NPW) dst = WaT + (size_t)(nl - NPW) * DM;
      else {
        const int gl = nl >> 8, c = nl & 255;
        int gp = gl;
        if (isin) { const int l2p[14] = {0, 4, 5, 6, 1, 7, 8, 9, 2, 10, 11, 12, 3, 13}; gp = l2p[gl]; }
        const int wc = c >> 6, bj = (c >> 5) & 1, t = c & 31, fq = t >> 3, n = (t >> 2) & 1, j = t & 3;
        const int pr = bj * 128 + wc * 32 + n * 16 + fq * 4 + j;
        dst = (isin ? WinT : WoutT) + (size_t)(gp * 256 + pr) * DM;
      }
      *(u32x4*)(dst + kt * 64 + kseg * 8) = w;
    }
  }
  __syncthreads();
}


__device__ __forceinline__ void phase_cachecvt(const Params& p, bf16_t* CKb, bf16_t* CVb) {
  const int tidx_ = otid(), bidx_ = obid(), gdim_ = ogdim(); (void)tidx_; (void)bidx_; (void)gdim_;
  for (int e = bidx_ * NTHREADS + tidx_; e < 2 * 262144; e += gdim_ * NTHREADS) {
    const bool isv = e >= 262144; const int o = (isv ? e - 262144 : e) * 8;
    *(u32x4*)((isv ? CVb : CKb) + o) = __builtin_bit_cast(u32x4, ld_f32x8_as_bf16(p.in[isv ? I_CV : I_CK] + o));
  }
}

__device__ __forceinline__ void phase_afb(const bf16_t* hN, const bf16_t* WaT, float* aFB) {
  const int tidx_ = otid(), bidx_ = obid(), gdim_ = ogdim(); (void)tidx_; (void)bidx_; (void)gdim_;
  const int lane = tidx_ & 63, wid = __builtin_amdgcn_readfirstlane(tidx_ >> 6), rr = lane & 31, hh = lane >> 5;
  const int nheavy = (gdim_ == 256) ? 64 : 0;
  if (bidx_ < nheavy) return;
  for (int it = (bidx_ - nheavy) * 8 + wid; it < MROWS / 32; it += (gdim_ - nheavy) * 8) {
    const bf16_t* a = hN + (size_t)(it * 32 + rr) * DM + hh * 8; const bf16_t* b = WaT + (size_t)rr * DM + hh * 8;
    f32x16 acc = zero16();
#pragma unroll 8
    for (int kk = 0; kk < 64; ++kk) acc = mfma32(ld_frag16(a + kk * 16), ld_frag16(b + kk * 16), acc);
#pragma unroll
    for (int i = 0; i < 16; ++i) { const int r = (i & 3) + 8 * (i >> 2) + 4 * hh; aFB[(size_t)(it * 32 + r) * 32 + rr] = acc[i]; }
  }
}

__device__ __forceinline__ void attn_ctx(bf16_t* P, bf16_t* Y, unsigned char* lds) {
  const int tidx_ = otid(), bidx_ = obid(), gdim_ = ogdim(); (void)tidx_; (void)bidx_; (void)gdim_;
  const int tid = tidx_, lane = tid & 63, wid = __builtin_amdgcn_readfirstlane(tid >> 6), rr = lane & 31, hh = lane >> 5;
  bf16_t* Ks = (bf16_t*)lds; bf16_t* Vt = (bf16_t*)(lds + 36864);
  for (int it = (bidx_ + 128) % gdim_; it < 128; it += gdim_) {
    const int b = it >> 2, h = it & 3; const size_t rb = (size_t)b * 256;
    __syncthreads();
#pragma unroll
    for (int i = 0; i < 4; ++i) { const int c = tid + 512 * i, key = c >> 3, part = c & 7; *(u32x4*)(Ks + key * 72 + part * 8) = *(const u32x4*)(P + (rb + key) * NPW + PKA + h * 64 + part * 8); }
    { const int kq = tid >> 3, part = tid & 7; u32x4 v[4];
#pragma unroll
      for (int i = 0; i < 4; ++i) v[i] = *(const u32x4*)(P + (rb + 4 * kq + i) * NPW + PVA + h * 64 + part * 8);
#pragma unroll
      for (int e = 0; e < 8; ++e) { const int wi = e >> 1; const bool hi = e & 1; unsigned s[4];
#pragma unroll
        for (int i = 0; i < 4; ++i) s[i] = hi ? (v[i][wi] >> 16) : (v[i][wi] & 0xffffu);
        u32x2 w; w.x = s[0] | (s[1] << 16); w.y = s[2] | (s[3] << 16);
        *(u32x2*)(Vt + (part * 8 + e) * 264 + 4 * kq) = w; } }
    __syncthreads();
    const size_t qrow = rb + wid * 32 + rr;
    bf16x8 qf[4];
#pragma unroll
    for (int ks = 0; ks < 4; ++ks) qf[ks] = ld_frag16(P + qrow * NPW + PQ + h * 64 + ks * 16 + hh * 8);
    float m = -1e30f, l = 0.f;
    f32x16 o[2]; o[0] = zero16(); o[1] = zero16();
#pragma unroll 1
    for (int half = 0; half < 2; ++half) {
      f32x16 acc[4];
#pragma unroll
      for (int j = 0; j < 4; ++j) { acc[j] = zero16(); const int kt = half * 4 + j;
#pragma unroll
        for (int ks = 0; ks < 4; ++ks) acc[j] = mfma32(ld_frag16(Ks + (kt * 32 + rr) * 72 + ks * 16 + hh * 8), qf[ks], acc[j]); }
      float mx = m;
#pragma unroll
      for (int j = 0; j < 4; ++j)
#pragma unroll
        for (int i = 0; i < 16; ++i) mx = fmaxf(mx, acc[j][i]);
      mx = fmaxf(mx, __shfl_xor(mx, 32));
      const float sc = __expf(m - mx); m = mx; l *= sc;
#pragma unroll
      for (int i = 0; i < 16; ++i) { o[0][i] *= sc; o[1][i] *= sc; }
#pragma unroll
      for (int j = 0; j < 4; ++j)
#pragma unroll
        for (int i = 0; i < 16; ++i) { const float e = __expf(acc[j][i] - mx); acc[j][i] = e; l += e; }
#pragma unroll
      for (int j = 0; j < 4; ++j)
#pragma unroll
        for (int s = 0; s < 2; ++s) { const bf16x8 pb = pack8(acc[j], s); const int kt = half * 4 + j;
#pragma unroll
          for (int dt = 0; dt < 2; ++dt) { const bf16_t* vp = Vt + (dt * 32 + rr) * 264 + kt * 32 + 16 * s + 4 * hh; o[dt] = mfma32(ld_frag8x2(vp, vp + 8), pb, o[dt]); } }
    }
    l += __shfl_xor(l, 32);
    const float inv = 1.f / l;
#pragma unroll
    for (int dt = 0; dt < 2; ++dt)
#pragma unroll
      for (int g4 = 0; g4 < 4; ++g4) { const int d = dt * 32 + 8 * g4 + 4 * hh;
        const u32x2 gw = *(const u32x2*)(P + qrow * NPW + PGA + h * 64 + d);
        u32x2 w; w.x = cvt_pk_bf16(o[dt][4 * g4] * inv * siluf(bflo(gw.x)), o[dt][4 * g4 + 1] * inv * siluf(bfhi(gw.x))); w.y = cvt_pk_bf16(o[dt][4 * g4 + 2] * inv * siluf(bflo(gw.y)), o[dt][4 * g4 + 3] * inv * siluf(bfhi(gw.y)));
        if (Y) *(u32x2*)(Y + qrow * NPW + PQ + h * 64 + d) = w; }
  }
  __syncthreads();
}

template <int MODE>
__device__ __forceinline__ void ad_tile(const bf16_t* Kt, const bf16_t* Vt_, const bf16x8 (&qf)[4], const float* brow, int cs, int rr, int hh, float& mx, float& l, f32x16 (&o)[2]) {
  f32x16 acc[2];
#pragma unroll
  for (int sub = 0; sub < 2; ++sub) { acc[sub] = zero16();
#pragma unroll
    for (int ks = 0; ks < 4; ++ks) acc[sub] = mfma32(ld_frag16(Kt + (sub * 32 + rr) * 72 + ks * 16 + hh * 8), qf[ks], acc[sub]); }
  float m2 = mx;
#pragma unroll
  for (int sub = 0; sub < 2; ++sub)
#pragma unroll
    for (int i = 0; i < 16; ++i) {
      const bool act = (MODE == 0) || (MODE == 1 ? (sub == 0 || i < 4) : (sub == 1 || i >= 12));
      if (act) {
        if (MODE != 0) { const int kc = sub * 32 + (i & 3) + 8 * (i >> 2) + 4 * hh; const bool ok = (kc >= cs) && (kc < cs + 16); acc[sub][i] = ok ? acc[sub][i] + brow[kc] : -1e30f; }
        m2 = fmaxf(m2, acc[sub][i]);
      }
    }
  m2 = fmaxf(m2, __shfl_xor(m2, 32));
  if (__any(m2 > mx + 8.f)) {
    const float sc = __expf(mx - m2); mx = m2; l *= sc;
#pragma unroll
    for (int i = 0; i < 16; ++i) { o[0][i] *= sc; o[1][i] *= sc; }
  }
#pragma unroll
  for (int sub = 0; sub < 2; ++sub)
#pragma unroll
    for (int i = 0; i < 16; ++i) {
      const bool act = (MODE == 0) || (MODE == 1 ? (sub == 0 || i < 4) : (sub == 1 || i >= 12));
      if (act) { const float e = __expf(acc[sub][i] - mx); acc[sub][i] = e; l += e; } else acc[sub][i] = 0.f;
    }
#pragma unroll
  for (int sub = 0; sub < 2; ++sub)
#pragma unroll
    for (int s = 0; s < 2; ++s) {
      const bool need = (MODE == 0) || (MODE == 1 ? (sub == 0 || s == 0) : (sub == 1 || s == 1));
      if (need) { const bf16x8 pb = pack8(acc[sub], s);
#pragma unroll
        for (int dt = 0; dt < 2; ++dt) { const bf16_t* vp = Vt_ + (dt * 32 + rr) * 72 + sub * 32 + 16 * s + 4 * hh; o[dt] = mfma32(ld_frag8x2(vp, vp + 8), pb, o[dt]); } }
    }
}

__device__ __forceinline__ void attn_den(const Params& p, int layer, bf16_t* P, bf16_t* Y, unsigned char* lds) {
  const int tidx_ = otid(), bidx_ = obid(), gdim_ = ogdim(); (void)tidx_; (void)bidx_; (void)gdim_;
  const int tid = tidx_, lane = tid & 63, wid = __builtin_amdgcn_readfirstlane(tid >> 6), rr = lane & 31, hh = lane >> 5;
  bf16_t* Kb = (bf16_t*)lds;
  bf16_t* Vb = (bf16_t*)(lds + 18432);
  float* rpbs = (float*)(lds + 36864);
  const bf16_t* CKb = (const bf16_t*)(p.ws + WS_CKB); const bf16_t* CVb = (const bf16_t*)(p.ws + WS_CVB); const float* rpb = p.in[I_RPB];
  const int skey = tid >> 3, spart = tid & 7;
  for (int it = bidx_; it < 256; it += gdim_) {
    const int b = it >> 6, h = (it >> 4) & 3, r0 = (it & 15) * 4;
    const size_t rb = (size_t)NCTXR + (size_t)b * 4096;
    const size_t cbase = (((size_t)b * 4 + layer) * 4 + h) * 512 * 64;
    const int r = r0 + (wid >> 1), qhalf = wid & 1;
    const int rs = min(max(r - 4, 0), 56);
    const int R0 = min(max(r0 - 4, 0), 56), nlat = min(max(r0 - 1, 0), 56) + 8 - R0, T = nlat + 8;
    __syncthreads();
    if (tid < 480) { const int dr = tid >> 5, dc = tid & 31; rpbs[tid] = dc < 31 ? rpb[(((size_t)layer * 4 + h) * 15 + dr) * 31 + dc] : 0.f; }
    const size_t qtok = rb + (size_t)r * 64 + qhalf * 32 + rr;
    bf16x8 qf[4];
#pragma unroll
    for (int ks = 0; ks < 4; ++ks) qf[ks] = ld_frag16(P + qtok * NPW + PQ + h * 64 + ks * 16 + hh * 8);
    const int qc = qhalf * 32 + rr; const int cs = min(max(qc - 8, 0), 48);
    u32x4 kA, vA, kB, vB;
#define AD_LOAD(j, kreg, vreg) do { if ((j) < nlat) { const size_t t0 = rb + (size_t)(R0 + (j)) * 64; \
        kreg = *(const u32x4*)(P + (t0 + skey) * NPW + PKA + h * 64 + spart * 8); \
        vreg = *(const u32x4*)(P + (t0 + skey) * NPW + PVA + h * 64 + spart * 8); \
      } else { const int c_ = (j) - nlat; \
        kreg = *(const u32x4*)(CKb + cbase + (size_t)(c_ * 64 + skey) * 64 + spart * 8); \
        vreg = *(const u32x4*)(CVb + cbase + (size_t)(c_ * 64 + skey) * 64 + spart * 8); } } while (0)
#define AD_WRITE(buf, kreg, vreg) do { *(u32x4*)(Kb + (buf) * 4608 + skey * 72 + spart * 8) = kreg; \
      _Pragma("unroll") for (int e_ = 0; e_ < 8; ++e_) { const unsigned w_ = vreg[e_ >> 1]; \
        Vb[(buf) * 4608 + (spart * 8 + e_) * 72 + skey] = (bf16_t)((e_ & 1) ? (w_ >> 16) : (w_ & 0xffffu)); } } while (0)
#define AD_COMPUTE(j) do { const int buf = (j) & 1; const bool lat = (j) < nlat; const int R = R0 + (j); \
      const bool use = !lat || (R >= rs && R < rs + 8); \
      if (use) { const bf16_t* Kt = Kb + buf * 4608; const bf16_t* Vt_ = Vb + buf * 4608; const float* brow = rpbs + (R - r + 7) * 32 + 15 - qc; \
        if (!lat) ad_tile<0>(Kt, Vt_, qf, brow, cs, rr, hh, mx, l, o); \
        else if (qhalf == 0) ad_tile<1>(Kt, Vt_, qf, brow, cs, rr, hh, mx, l, o); \
        else ad_tile<2>(Kt, Vt_, qf, brow, cs, rr, hh, mx, l, o); } } while (0)
    AD_LOAD(0, kB, vB);
    AD_WRITE(0, kB, vB);
    AD_LOAD(1, kA, vA);
    __syncthreads();
    float mx = -1e30f, l = 0.f;
    f32x16 o[2]; o[0] = zero16(); o[1] = zero16();
#pragma unroll 1
    for (int j = 0; j < T; j += 2) {
      if (j + 2 < T) AD_LOAD(j + 2, kB, vB);
      AD_COMPUTE(j);
      if (j + 1 < T) AD_WRITE(1, kA, vA);
      __syncthreads();
      if (j + 1 < T) {
        if (j + 3 < T) AD_LOAD(j + 3, kA, vA);
        AD_COMPUTE(j + 1);
        if (j + 2 < T) AD_WRITE(0, kB, vB);
        __syncthreads();
      }
    }
#undef AD_LOAD
#undef AD_WRITE
#undef AD_COMPUTE
    l += __shfl_xor(l, 32);
    const float inv = 1.f / l;
#pragma unroll
    for (int dt = 0; dt < 2; ++dt)
#pragma unroll
      for (int g4 = 0; g4 < 4; ++g4) { const int d = dt * 32 + 8 * g4 + 4 * hh;
        const u32x2 gw = *(const u32x2*)(P + qtok * NPW + PGA + h * 64 + d);
        u32x2 w; w.x = cvt_pk_bf16(o[dt][4 * g4] * inv * siluf(bflo(gw.x)), o[dt][4 * g4 + 1] * inv * siluf(bfhi(gw.x))); w.y = cvt_pk_bf16(o[dt][4 * g4 + 2] * inv * siluf(bflo(gw.y)), o[dt][4 * g4 + 3] * inv * siluf(bfhi(gw.y)));
        if (Y) *(u32x2*)(Y + qtok * NPW + PQ + h * 64 + d) = w; }
  }
  __syncthreads();
}

__device__ __forceinline__ void conv_mix(const Params& p, int layer, bf16_t* P, bf16_t* Y) {
  const int tidx_ = otid(), bidx_ = obid(), gdim_ = ogdim(); (void)tidx_; (void)bidx_; (void)gdim_;
  const float* cw = p.in[I_CONV] + layer * 768;
  const long long total = (long long)MROWS * 32, stride = (long long)gdim_ * NTHREADS;
  for (long long e0 = (long long)bidx_ * NTHREADS + tidx_; e0 < total; e0 += 2 * stride) {
    u32x4 cv[2][3], hv[2][3], bv[2], gv[2]; float ml[2], mr[2]; int rowv[2], cc[2]; bool live[2];
#pragma unroll
    for (int q = 0; q < 2; ++q) {
      const long long e = e0 + q * stride; live[q] = e < total; const long long ee = live[q] ? e : e0;
      const int row = (int)(ee >> 5), c = (int)(ee & 31) * 8; rowv[q] = row; cc[q] = c;
      int s, S; if (row < NCTXR) { s = row & 255; S = 256; } else { s = (row - NCTXR) & 4095; S = 4096; }
      const bool hl = s > 0, hr = s < S - 1; ml[q] = hl ? 1.f : 0.f; mr[q] = hr ? 1.f : 0.f;
      const bf16_t* pr = P + (size_t)row * NPW; const bf16_t* pl = hl ? pr - NPW : pr; const bf16_t* pn = hr ? pr + NPW : pr;
      cv[q][0] = *(const u32x4*)(pl + PCB + c); hv[q][0] = *(const u32x4*)(pl + PHB + c);
      cv[q][1] = *(const u32x4*)(pr + PCB + c); hv[q][1] = *(const u32x4*)(pr + PHB + c);
      cv[q][2] = *(const u32x4*)(pn + PCB + c); hv[q][2] = *(const u32x4*)(pn + PHB + c);
      bv[q] = *(const u32x4*)(pr + PBB + c); gv[q] = *(const u32x4*)(pr + PGB + c);
    }
#pragma unroll
    for (int q = 0; q < 2; ++q) {
      const int c = cc[q];
      float y[8];
#pragma unroll
      for (int j = 0; j < 8; ++j) {
        const int wj = j >> 1; const bool hi = j & 1;
        const float u0 = (hi ? bfhi(cv[q][0][wj]) * bfhi(hv[q][0][wj]) : bflo(cv[q][0][wj]) * bflo(hv[q][0][wj])) * ml[q];
        const float u1 = hi ? bfhi(cv[q][1][wj]) * bfhi(hv[q][1][wj]) : bflo(cv[q][1][wj]) * bflo(hv[q][1][wj]);
        const float u2 = (hi ? bfhi(cv[q][2][wj]) * bfhi(hv[q][2][wj]) : bflo(cv[q][2][wj]) * bflo(hv[q][2][wj])) * mr[q];
        const float conv = u0 * cw[c + j] + u1 * cw[256 + c + j] + u2 * cw[512 + c + j];
        const float bb = hi ? bfhi(bv[q][wj]) : bflo(bv[q][wj]); const float gg = siluf(hi ? bfhi(gv[q][wj]) : bflo(gv[q][wj]));
        y[j] = bb * conv * gg;
      }
      u32x4 w; w.x = cvt_pk_bf16(y[0], y[1]); w.y = cvt_pk_bf16(y[2], y[3]); w.z = cvt_pk_bf16(y[4], y[5]); w.w = cvt_pk_bf16(y[6], y[7]);
      if (Y && live[q]) *(u32x4*)(Y + (size_t)rowv[q] * NPW + PBB + c) = w;
    }
  }
}

__device__ __forceinline__ void fourier_tables(unsigned char* lds) {
  const int tidx_ = otid(), bidx_ = obid(), gdim_ = ogdim(); (void)tidx_; (void)bidx_; (void)gdim_;
  bf16_t* T = (bf16_t*)lds;
  for (int e = tidx_; e < 4096; e += NTHREADS) { const int a = e >> 6, b = e & 63; const float x = (float)((a * b) & 63) * (1.f / 64.f);
    T[a * 72 + b] = f2bf(__builtin_amdgcn_cosf(x)); T[4608 + a * 72 + b] = f2bf(__builtin_amdgcn_sinf(x));
    const bool in4 = (a < 32) && (b < 32) && ((a >> 2) == (b >> 2)); const float y = (float)(((a & 3) * (b & 3)) & 3) * 0.25f;
    T[9216 + a * 72 + b] = in4 ? f2bf(__builtin_amdgcn_cosf(y)) : (bf16_t)0; T[13824 + a * 72 + b] = in4 ? f2bf(__builtin_amdgcn_sinf(y)) : (bf16_t)0; }
}
__device__ __forceinline__ bf16x8 neg_bf16x8(bf16x8 v) { u32x4 w = __builtin_bit_cast(u32x4, v); w.x ^= 0x80008000u; w.y ^= 0x80008000u; w.z ^= 0x80008000u; w.w ^= 0x80008000u; return as_bf16x8(w); }

template <bool DEN>
__device__ __forceinline__ void fourier1_item(int t2, const bf16_t* P, bf16_t* Zr, bf16_t* Zi, unsigned char* lds) {
  const int tidx_ = otid(), bidx_ = obid(), gdim_ = ogdim(); (void)tidx_; (void)bidx_; (void)gdim_;
  const int tid = tidx_, lane = tid & 63, wid = __builtin_amdgcn_readfirstlane(tid >> 6), rr = lane & 31, hh = lane >> 5;
  const bf16_t* T = (const bf16_t*)lds;
  bf16_t* Xr = (bf16_t*)(lds + 36864); bf16_t* Xi = (bf16_t*)(lds + 36864 + 32768);
  constexpr int NS1 = DEN ? 64 : 4, NKAT = DEN ? 2 : 1, NSS = DEN ? 4 : 1, NST = DEN ? 2 : 1;
  const int jh = t2 & 1, sblk = (t2 >> 1) & 7, bg = t2 >> 4, g = bg & 3, b = bg >> 2;
  const size_t rb = DEN ? (size_t)NCTXR + (size_t)b * 4096 : (size_t)b * 256;
  const int s2 = sblk * 8 + wid;
  const bf16_t* Tc = DEN ? T : T + 9216; const bf16_t* Ts = DEN ? T + 4608 : T + 13824;
  f32x16 uc[NST], us[NST];
  {
    bf16x8 bc[4], bs[4];
#pragma unroll
    for (int ks = 0; ks < 4; ++ks) { bc[ks] = ld_frag16(T + (jh * 32 + rr) * 72 + ks * 16 + hh * 8); bs[ks] = ld_frag16(T + 4608 + (jh * 32 + rr) * 72 + ks * 16 + hh * 8); }
#pragma unroll
    for (int st = 0; st < NST; ++st) { uc[st] = zero16(); us[st] = zero16();
      const int s1 = st * 32 + rr; const bool valid = s1 < NS1;
      const bf16_t* up = P + (rb + (size_t)(valid ? s1 : 0) * 64 + s2) * NPW + PUC + g * 64 + hh * 8;
#pragma unroll
      for (int ks = 0; ks < 4; ++ks) { u32x4 raw = *(const u32x4*)(up + ks * 16); if (!valid) raw = (u32x4){0u, 0u, 0u, 0u}; const bf16x8 a = as_bf16x8(raw); uc[st] = mfma32(a, bc[ks], uc[st]); us[st] = mfma32(a, bs[ks], us[st]); } }
  }
  bf16x8 puc[NSS], pus[NSS], pun[NSS];
#pragma unroll
  for (int s = 0; s < NSS; ++s) { puc[s] = pack8(uc[s >> 1], s & 1); pus[s] = pack8(us[s >> 1], s & 1); pun[s] = neg_bf16x8(pus[s]); }
  constexpr float nrm = DEN ? (1.f / 512.f) : (1.f / 128.f), invS = DEN ? (1.f / 4096.f) : (1.f / 256.f);
  __syncthreads();
#pragma unroll
  for (int kat = 0; kat < NKAT; ++kat) {
    f32x16 yr = zero16(), ys = zero16();
#pragma unroll
    for (int s = 0; s < NSS; ++s) {
      const bf16_t* tc = Tc + (kat * 32 + rr) * 72 + 16 * s + 4 * hh; const bf16_t* ts = Ts + (kat * 32 + rr) * 72 + 16 * s + 4 * hh;
      const bf16x8 ac = ld_frag8x2(tc, tc + 8), as = ld_frag8x2(ts, ts + 8);
      yr = mfma32(ac, puc[s], yr); yr = mfma32(as, pun[s], yr);
      ys = mfma32(ac, pus[s], ys); ys = mfma32(as, puc[s], ys);
    }
#pragma unroll
    for (int i = 0; i < 16; ++i) { const int ka = kat * 32 + (i & 3) + 8 * (i >> 2) + 4 * hh;
      const float th = (float)((ka * s2) & (DEN ? 4095 : 255)) * invS; const float c = __builtin_amdgcn_cosf(th), s = __builtin_amdgcn_sinf(th);
      const float zr = (yr[i] * c - ys[i] * s) * nrm, zi = (-ys[i] * c - yr[i] * s) * nrm;
      Xr[(ka * 32 + rr) * 8 + wid] = f2bf(zr); Xi[(ka * 32 + rr) * 8 + wid] = f2bf(zi); }
  }
  __syncthreads();
  { constexpr int nka = DEN ? 64 : 4; const size_t zb = DEN ? (size_t)512 + (size_t)bg * 64 : (size_t)bg * 4;
    for (int c = tid; c < nka * 32; c += NTHREADS) { const int ka = c >> 5, jl = c & 31;
      const size_t zo = ((zb + ka) * 64 + jh * 32 + jl) * 64 + sblk * 8;
      *(u32x4*)(Zr + zo) = *(const u32x4*)(Xr + c * 8); *(u32x4*)(Zi + zo) = *(const u32x4*)(Xi + c * 8); } }
}
__device__ __forceinline__ void fourier1_ctx(const bf16_t* P, bf16_t* Zr, bf16_t* Zi, unsigned char* lds) {
  const int tidx_ = otid(), bidx_ = obid(), gdim_ = ogdim(); (void)tidx_; (void)bidx_; (void)gdim_;
  const int tid = tidx_, lane = tid & 63, wid = __builtin_amdgcn_readfirstlane(tid >> 6), rr = lane & 31, hh = lane >> 5;
  const bf16_t* T = (const bf16_t*)lds;
  for (int it = bidx_ * 8 + wid; it < 1024; it += gdim_ * 8) {
    const int sblk = it & 7, bg = it >> 3, g = bg & 3, b = bg >> 2;
    const size_t rb = (size_t)b * 256;
    const bf16_t* up = P + (rb + (size_t)(rr & 3) * 64 + sblk * 8 + (rr >> 2)) * NPW + PUC + g * 64 + hh * 8;
    bf16x8 a[4];
#pragma unroll
    for (int ks = 0; ks < 4; ++ks) a[ks] = ld_frag16(up + ks * 16);
#pragma unroll 1
    for (int jt = 0; jt < 2; ++jt) {
      f32x16 uc = zero16(), us = zero16();
#pragma unroll
      for (int ks = 0; ks < 4; ++ks) { uc = mfma32(a[ks], ld_frag16(T + (jt * 32 + rr) * 72 + ks * 16 + hh * 8), uc); us = mfma32(a[ks], ld_frag16(T + 4608 + (jt * 32 + rr) * 72 + ks * 16 + hh * 8), us); }
      f32x16 yr = zero16(), ys = zero16();
#pragma unroll
      for (int s = 0; s < 2; ++s) {
        const bf16x8 puc = pack8(uc, s), pus = pack8(us, s), pun = neg_bf16x8(pus);
        const bf16_t* tc = T + 9216 + rr * 72 + 16 * s + 4 * hh; const bf16_t* ts = T + 13824 + rr * 72 + 16 * s + 4 * hh;
        const bf16x8 ac = ld_frag8x2(tc, tc + 8), as = ld_frag8x2(ts, ts + 8);
        yr = mfma32(ac, puc, yr); yr = mfma32(as, pun, yr);
        ys = mfma32(ac, pus, ys); ys = mfma32(as, puc, ys);
      }
      float zr[16], zi[16];
#pragma unroll
      for (int i = 0; i < 16; ++i) { const int ka = i & 3, s2 = sblk * 8 + 2 * (i >> 2) + hh;
        const float th = (float)((ka * s2) & 255) * (1.f / 256.f); const float c = __builtin_amdgcn_cosf(th), s = __builtin_amdgcn_sinf(th);
        zr[i] = (yr[i] * c - ys[i] * s) * (1.f / 128.f); zi[i] = (-ys[i] * c - yr[i] * s) * (1.f / 128.f); }
#pragma unroll
      for (int ka = 0; ka < 4; ++ka) {
        u32x4 wr_, wi_;
#pragma unroll
        for (int m = 0; m < 4; ++m) {
          const float mr = zr[ka + 4 * m], mi = zi[ka + 4 * m];
          const float orr = __shfl_xor(mr, 32), oi = __shfl_xor(mi, 32);
          wr_[m] = hh ? cvt_pk_bf16(orr, mr) : cvt_pk_bf16(mr, orr);
          wi_[m] = hh ? cvt_pk_bf16(oi, mi) : cvt_pk_bf16(mi, oi);
        }
        const size_t zo = (((size_t)bg * 4 + ka) * 64 + jt * 32 + rr) * 64 + sblk * 8;
        if (hh == 0) *(u32x4*)(Zr + zo) = wr_; else *(u32x4*)(Zi + zo) = wi_;
      }
    }
  }
}
__device__ __forceinline__ void fourier1(const bf16_t* P, bf16_t* Zr, bf16_t* Zi, unsigned char* lds) {
  const int tidx_ = otid(), bidx_ = obid(), gdim_ = ogdim(); (void)tidx_; (void)bidx_; (void)gdim_;
  __syncthreads();
  fourier_tables(lds);
  __syncthreads();
#pragma unroll 1
  for (int it = bidx_; it < 256; it += gdim_) fourier1_item<true>(it, P, Zr, Zi, lds);
  fourier1_ctx(P, Zr, Zi, lds);
  __syncthreads();
}

__device__ __forceinline__ void fourier2(bf16_t* P, const bf16_t* Zr, const bf16_t* Zi, unsigned char* lds) {
  const int tidx_ = otid(), bidx_ = obid(), gdim_ = ogdim(); (void)tidx_; (void)bidx_; (void)gdim_;
  const int tid = tidx_, lane = tid & 63, wid = __builtin_amdgcn_readfirstlane(tid >> 6), rr = lane & 31, hh = lane >> 5;
  const bf16_t* T = (const bf16_t*)lds;
  __syncthreads();
  fourier_tables(lds);
  __syncthreads();
  for (int it = bidx_ * 8 + wid; it < 1024 + 512; it += gdim_ * 8) {
    const bool den = it < 1024; const int t2 = den ? it : it - 1024;
    int ka, bg; if (den) { ka = t2 & 63; bg = t2 >> 6; } else { ka = t2 & 3; bg = t2 >> 2; }
    const int g = bg & 3, b = bg >> 2; const int NS1 = den ? 64 : 4;
    const size_t rb = den ? (size_t)NCTXR + (size_t)b * 4096 : (size_t)b * 256;
    const size_t zb = ((den ? (size_t)512 + (size_t)bg * 64 : (size_t)bg * 4) + ka) * 4096;
    bf16x8 zr[2][4], zi[2][4]; u32x2 gwv[2][2][4];
#pragma unroll
    for (int jt = 0; jt < 2; ++jt)
#pragma unroll
      for (int s = 0; s < 4; ++s) { const size_t o = zb + (size_t)(jt * 32 + rr) * 64 + 16 * s + 8 * hh; zr[jt][s] = ld_frag16(Zr + o); zi[jt][s] = ld_frag16(Zi + o); }
#pragma unroll
    for (int jt = 0; jt < 2; ++jt)
#pragma unroll
      for (int kbt = 0; kbt < 2; ++kbt) { const size_t tok = rb + ka + (size_t)NS1 * (kbt * 32 + rr);
#pragma unroll
        for (int g4 = 0; g4 < 4; ++g4) gwv[jt][kbt][g4] = *(const u32x2*)(P + tok * NPW + PGC + g * 64 + jt * 32 + 8 * g4 + 4 * hh); }
#pragma unroll
    for (int jt = 0; jt < 2; ++jt) {
#pragma unroll
      for (int kbt = 0; kbt < 2; ++kbt) {
        f32x16 x = zero16();
#pragma unroll
        for (int s = 0; s < 4; ++s) { x = mfma32(zr[jt][s], ld_frag16(T + (kbt * 32 + rr) * 72 + 16 * s + 8 * hh), x); x = mfma32(zi[jt][s], ld_frag16(T + 4608 + (kbt * 32 + rr) * 72 + 16 * s + 8 * hh), x); }
        const size_t tok = rb + ka + (size_t)NS1 * (kbt * 32 + rr);
#pragma unroll
        for (int g4 = 0; g4 < 4; ++g4) { const int ch = g * 64 + jt * 32 + 8 * g4 + 4 * hh;
          const u32x2 gw = gwv[jt][kbt][g4];
          u32x2 w; w.x = cvt_pk_bf16(x[4 * g4] * siluf(bflo(gw.x)), x[4 * g4 + 1] * siluf(bfhi(gw.x))); w.y = cvt_pk_bf16(x[4 * g4 + 2] * siluf(bflo(gw.y)), x[4 * g4 + 3] * siluf(bfhi(gw.y)));
          *(u32x2*)(P + tok * NPW + PUC + ch) = w; }
      }
    }
  }
}

__device__ __forceinline__ int gla_slot(bool den, int b, int h, int dir) { return den ? 1024 + ((b * 4 + h) * 2 + dir) * 64 : ((b * 4 + h) * 2 + dir) * 4; }
__device__ __forceinline__ void gla_decay(const Params& p, int layer, int h, size_t rb, const float* aFB, float* SEGv, int tt, int dkt, int rr, int hh, float (&G)[2][16], float (&tot)[2]) {
  const int dkc = dkt * 32 + rr;
  const int tau = 16 * ((rr >> 2) & 1) + (rr & 3) + 4 * (rr >> 3);
#pragma unroll
  for (int dir = 0; dir < 2; ++dir) {
    const float* up = p.in[dir ? I_UPB : I_UPF] + (size_t)layer * 16 * 256 + h * 64 + dkc + (size_t)(8 * hh) * 256;
    u32x4 ub; ub.x = cvt_pk_bf16(up[0], up[256]); ub.y = cvt_pk_bf16(up[512], up[768]); ub.z = cvt_pk_bf16(up[1024], up[1280]); ub.w = cvt_pk_bf16(up[1536], up[1792]);
    const float bias = p.in[dir ? I_BB : I_BF][layer * 256 + h * 64 + dkc];
    const bf16x8 af = ld_f32x8_as_bf16(aFB + (rb + tt * 32 + tau) * 32 + dir * 16 + 8 * hh);
    const f32x16 z = mfma32(af, as_bf16x8(ub), zero16());
    float run = 0.f;
    if (dir == 0) {
#pragma unroll
      for (int i = 0; i < 16; ++i) { run += logsigf(z[i] + bias) * (1.f / 16.f); G[0][i] = run; }
    } else {
#pragma unroll
      for (int i = 15; i >= 0; --i) { run += logsigf(z[i] + bias) * (1.f / 16.f); G[1][i] = run; }
    }
    SEGv[(dir * 4 + tt * 2 + hh) * 64 + dkc] = run;
  }
  __syncthreads();
#pragma unroll
  for (int dir = 0; dir < 2; ++dir) {
    float run = 0.f, excl = 0.f, incl = 0.f;
#pragma unroll
    for (int s = 0; s < 4; ++s) { const float v = SEGv[(dir * 4 + s) * 64 + dkc]; const bool mine = (s == tt * 2 + hh); excl = mine ? run : excl; incl = mine ? run + v : incl; run += v; }
    tot[dir] = run;
    const float off = dir ? (run - incl) : excl;
#pragma unroll
    for (int i = 0; i < 16; ++i) G[dir][i] += off;
  }
}
__device__ __forceinline__ void gla1(const Params& p, int layer, const bf16_t* P, const float* aFB, bf16_t* ST, float* DEC, unsigned char* lds) {
  const int tidx_ = otid(), bidx_ = obid(), gdim_ = ogdim(); (void)tidx_; (void)bidx_; (void)gdim_;
  const int tid = tidx_, lane = tid & 63, wid = __builtin_amdgcn_readfirstlane(tid >> 6), rr = lane & 31, hh = lane >> 5;
  const int half = wid >> 2, lw = wid & 3, ltid = tid & 255;
  unsigned char* lb = lds + half * 40960;
  bf16_t* KE = (bf16_t*)lb;
  bf16_t* VT = (bf16_t*)(lb + 18432);
  float* SEGv = (float*)(lb + 27648);
  const int tt = lw & 1, dkt = lw >> 1, dkc = dkt * 32 + rr;
  for (int it2 = bidx_; it2 < 768; it2 += gdim_) {
    const int it = it2 * 2 + half;
    bool den; int b, h, n, NC;
    if (it < 1024) { den = true; NC = 64; n = it & 63; h = (it >> 6) & 3; b = it >> 8; }
    else { const int t2 = it - 1024; den = false; NC = 4; n = t2 & 3; h = (t2 >> 2) & 3; b = t2 >> 4; }
    const size_t rb = (den ? (size_t)NCTXR + (size_t)b * 4096 : (size_t)b * 256) + (size_t)n * 64;
    float kv[16];
#pragma unroll
    for (int i = 0; i < 16; ++i) kv[i] = bf2f(P[(rb + tt * 32 + 16 * hh + i) * NPW + PKD + h * 64 + dkc]);
    u32x4 vst[4];
    if (ltid < 128) {
#pragma unroll
      for (int i = 0; i < 4; ++i) vst[i] = *(const u32x4*)(P + (rb + 4 * (ltid >> 3) + i) * NPW + PVD + h * 64 + (ltid & 7) * 8);
    }
    __syncthreads();
    float G[2][16], tot[2];
    gla_decay(p, layer, h, rb, aFB, SEGv, tt, dkt, rr, hh, G, tot);
#pragma unroll
    for (int dir = 0; dir < 2; ++dir) {
      { float e[16];
#pragma unroll
        for (int q = 0; q < 16; ++q) e[q] = kv[q] * __expf(tot[dir] - G[dir][q]);
        u32x4 w0, w1;
        w0.x = cvt_pk_bf16(e[0], e[1]); w0.y = cvt_pk_bf16(e[2], e[3]); w0.z = cvt_pk_bf16(e[4], e[5]); w0.w = cvt_pk_bf16(e[6], e[7]);
        w1.x = cvt_pk_bf16(e[8], e[9]); w1.y = cvt_pk_bf16(e[10], e[11]); w1.z = cvt_pk_bf16(e[12], e[13]); w1.w = cvt_pk_bf16(e[14], e[15]);
        *(u32x4*)(KE + dir * 4608 + dkc * 72 + tt * 32 + 16 * hh) = w0; *(u32x4*)(KE + dir * 4608 + dkc * 72 + tt * 32 + 16 * hh + 8) = w1; }
      if (tt == 0 && hh == 0) { const int slot = gla_slot(den, b, h, dir) + (dir ? NC - 1 - n : n); DEC[(size_t)slot * 64 + dkc] = __expf(tot[dir]); }
    }
    if (ltid < 128) {
      const int tq2 = ltid >> 3, part = ltid & 7;
#pragma unroll
      for (int e = 0; e < 8; ++e) { const int wi = e >> 1; const bool hi = e & 1; unsigned s[4];
#pragma unroll
        for (int i = 0; i < 4; ++i) s[i] = hi ? (vst[i][wi] >> 16) : (vst[i][wi] & 0xffffu);
        u32x2 w; w.x = s[0] | (s[1] << 16); w.y = s[2] | (s[3] << 16);
        *(u32x2*)(VT + (part * 8 + e) * 72 + 4 * tq2) = w; }
    }
    __syncthreads();
    {
      const int dkt2 = lw & 1, dvt = lw >> 1;
#pragma unroll
      for (int dir = 0; dir < 2; ++dir) {
        f32x16 acc = zero16();
#pragma unroll
        for (int ks = 0; ks < 4; ++ks) acc = mfma32(ld_frag16(KE + dir * 4608 + (dkt2 * 32 + rr) * 72 + ks * 16 + hh * 8), ld_frag16(VT + (dvt * 32 + rr) * 72 + ks * 16 + hh * 8), acc);
        const int slot = gla_slot(den, b, h, dir) + (dir ? NC - 1 - n : n);
        bf16_t* st = ST + (size_t)slot * 4096 + (dvt * 32 + rr) * 64 + dkt2 * 32 + 4 * hh;
#pragma unroll
        for (int g4 = 0; g4 < 4; ++g4) { u32x2 w; w.x = cvt_pk_bf16(acc[4 * g4], acc[4 * g4 + 1]); w.y = cvt_pk_bf16(acc[4 * g4 + 2], acc[4 * g4 + 3]); *(u32x2*)(st + 8 * g4) = w; }
      }
    }
  }
  __syncthreads();
}
__device__ __forceinline__ void gla2(const Params& p, int layer, bf16_t* ST, const float* DEC) {
  const int tidx_ = otid(), bidx_ = obid(), gdim_ = ogdim(); (void)tidx_; (void)bidx_; (void)gdim_;
  const float* sg = p.in[I_SG];
  for (int it = bidx_; it < 512; it += gdim_) {
    const int e = (it & 7) * 512 + tidx_, dv = e >> 6, dk = e & 63;
    if (it < 256) {
      const int s2 = it >> 3; const int dir = s2 & 1, h = (s2 >> 1) & 3, b = s2 >> 3;
      const int slot0 = gla_slot(true, b, h, dir);
      float S = sg[(((((size_t)b * 4 + layer) * 2 + dir) * 4 + h) * 64 + dk) * 64 + dv];
#pragma unroll 1
      for (int n0 = 0; n0 < 64; n0 += 32) {
        float u[32], d[32];
#pragma unroll
        for (int j = 0; j < 32; ++j) { u[j] = bf2f(ST[(size_t)(slot0 + n0 + j) * 4096 + e]); d[j] = DEC[(size_t)(slot0 + n0 + j) * 64 + dk]; }
#pragma unroll
        for (int j = 0; j < 32; ++j) { ST[(size_t)(slot0 + n0 + j) * 4096 + e] = f2bf(S); S = d[j] * S + u[j]; }
      }
    } else {
      const int oct = (it - 256) >> 3;
      float u[8][4], d[8][4];
#pragma unroll
      for (int q = 0; q < 8; ++q) { const int slot0 = (oct * 8 + q) * 4;
#pragma unroll
        for (int j = 0; j < 4; ++j) { u[q][j] = bf2f(ST[(size_t)(slot0 + j) * 4096 + e]); d[q][j] = DEC[(size_t)(slot0 + j) * 64 + dk]; } }
#pragma unroll
      for (int q = 0; q < 8; ++q) { const int s2 = oct * 8 + q; const int dir = s2 & 1, h = (s2 >> 1) & 3, b = s2 >> 3; const int slot0 = s2 * 4;
        float S = 0.f;
#pragma unroll
        for (int j = 0; j < 4; ++j) { ST[(size_t)(slot0 + j) * 4096 + e] = f2bf(S); S = d[q][j] * S + u[q][j]; }
        p.out[OFF_ST + (((((size_t)b * 4 + layer) * 2 + dir) * 4 + h) * 64 + dk) * 64 + dv] = S; }
    }
  }
}
__device__ __forceinline__ void gla3(const Params& p, int layer, bf16_t* P, bf16_t* Y, const float* aFB, const bf16_t* ST, unsigned char* lds) {
  const int tidx_ = otid(), bidx_ = obid(), gdim_ = ogdim(); (void)tidx_; (void)bidx_; (void)gdim_;
  const int tid = tidx_, lane = tid & 63, wid = __builtin_amdgcn_readfirstlane(tid >> 6), rr = lane & 31, hh = lane >> 5;
  const int half = wid >> 2, lw = wid & 3, ltid = tid & 255;
  unsigned char* lb = lds + half * 65536;
  bf16_t* QD = (bf16_t*)lb;
  bf16_t* KI = (bf16_t*)(lb + 18432);
  bf16_t* VT = (bf16_t*)(lb + 36864);
  float* SS = (float*)(lb + 46080);
  float* SEG = (float*)(lb + 46592);
  const float* gn = p.in[I_GN] + layer * 64;
  for (int it2 = bidx_; it2 < 768; it2 += gdim_) {
    const int it = it2 * 2 + half;
    bool den; int b, h, n, NC;
    if (it < 1024) { den = true; NC = 64; n = it & 63; h = (it >> 6) & 3; b = it >> 8; }
    else { const int t2 = it - 1024; den = false; NC = 4; n = t2 & 3; h = (t2 >> 2) & 3; b = t2 >> 4; }
    const size_t rb = (den ? (size_t)NCTXR + (size_t)b * 4096 : (size_t)b * 256) + (size_t)n * 64;
    const int tt = lw & 1, dvt = lw >> 1;
    bf16x8 stf[2][4]; u32x2 gwv[4];
#pragma unroll
    for (int dir = 0; dir < 2; ++dir) { const int slot = gla_slot(den, b, h, dir) + (dir ? NC - 1 - n : n); const bf16_t* st = ST + (size_t)slot * 4096 + (dvt * 32 + rr) * 64 + hh * 8;
#pragma unroll
      for (int ks = 0; ks < 4; ++ks) stf[dir][ks] = ld_frag16(st + ks * 16); }
    { const size_t tok2 = rb + tt * 32 + rr;
#pragma unroll
      for (int g4 = 0; g4 < 4; ++g4) gwv[g4] = *(const u32x2*)(P + tok2 * NPW + PGD + h * 64 + dvt * 32 + 8 * g4 + 4 * hh); }
    const int dkt = dvt, dkc = dkt * 32 + rr;
    float qv[16], kv[16];
#pragma unroll
    for (int i = 0; i < 16; ++i) { const size_t tok = rb + tt * 32 + 16 * hh + i; qv[i] = bf2f(P[tok * NPW + PQD + h * 64 + dkc]); kv[i] = bf2f(P[tok * NPW + PKD + h * 64 + dkc]); }
    u32x4 vst[4];
    if (ltid < 128) {
#pragma unroll
      for (int i = 0; i < 4; ++i) vst[i] = *(const u32x4*)(P + (rb + 4 * (ltid >> 3) + i) * NPW + PVD + h * 64 + (ltid & 7) * 8);
    }
    __syncthreads();
    float G[2][16], tot[2];
    gla_decay(p, layer, h, rb, aFB, SEG, tt, dkt, rr, hh, G, tot);
#pragma unroll
    for (int dir = 0; dir < 2; ++dir)
#pragma unroll
      for (int i = 0; i < 16; ++i) { const int t = tt * 32 + 16 * hh + i;
        QD[dir * 4608 + t * 72 + dkc] = f2bf(qv[i] * __expf(G[dir][i])); KI[dir * 4608 + t * 72 + dkc] = f2bf(kv[i] * __expf(-G[dir][i])); }
    if (ltid < 128) {
      const int tq2 = ltid >> 3, part = ltid & 7;
#pragma unroll
      for (int e = 0; e < 8; ++e) { const int wi = e >> 1; const bool hi = e & 1; unsigned s[4];
#pragma unroll
        for (int i = 0; i < 4; ++i) s[i] = hi ? (vst[i][wi] >> 16) : (vst[i][wi] & 0xffffu);
        u32x2 w; w.x = s[0] | (s[1] << 16); w.y = s[2] | (s[3] << 16);
        *(u32x2*)(VT + (part * 8 + e) * 72 + 4 * tq2) = w; }
    }
    __syncthreads();
    f32x16 o = zero16();
#pragma unroll
    for (int dir = 0; dir < 2; ++dir) {
      bf16x8 qf[4];
#pragma unroll
      for (int ks = 0; ks < 4; ++ks) qf[ks] = ld_frag16(QD + dir * 4608 + (tt * 32 + rr) * 72 + ks * 16 + hh * 8);
#pragma unroll
      for (int st = 0; st < 2; ++st) {
        const bool use = dir ? (st >= tt) : (st <= tt);
        if (use) {
          f32x16 a = zero16();
#pragma unroll
          for (int ks = 0; ks < 4; ++ks) a = mfma32(ld_frag16(KI + dir * 4608 + (st * 32 + rr) * 72 + ks * 16 + hh * 8), qf[ks], a);
          const int t = tt * 32 + rr;
#pragma unroll
          for (int i = 0; i < 16; ++i) { const int s = st * 32 + (i & 3) + 8 * (i >> 2) + 4 * hh; const bool keep = dir ? (s >= t) : (s <= t); a[i] = keep ? a[i] : 0.f; }
#pragma unroll
          for (int sk = 0; sk < 2; ++sk) { const bf16_t* vp = VT + (dvt * 32 + rr) * 72 + st * 32 + 16 * sk + 4 * hh; o = mfma32(ld_frag8x2(vp, vp + 8), pack8(a, sk), o); }
        }
      }
#pragma unroll
      for (int ks = 0; ks < 4; ++ks) o = mfma32(stf[dir][ks], qf[ks], o);
    }
    float ss = 0.f;
#pragma unroll
    for (int i = 0; i < 16; ++i) ss += o[i] * o[i];
    ss += __shfl_xor(ss, 32);
    if (hh == 0) SS[dvt * 64 + tt * 32 + rr] = ss;
    __syncthreads();
    {
      const float tot = SS[tt * 32 + rr] + SS[64 + tt * 32 + rr];
      const float rstd = rsqrtf(tot * (1.f / 64.f) + 1e-6f);
      const size_t tok = rb + tt * 32 + rr;
#pragma unroll
      for (int g4 = 0; g4 < 4; ++g4) { const int dv = dvt * 32 + 8 * g4 + 4 * hh;
        const u32x2 gw = gwv[g4]; const f32x4 gg = *(const f32x4*)(gn + dv);
        u32x2 w; w.x = cvt_pk_bf16(o[4 * g4] * rstd * gg[0] * siluf(bflo(gw.x)), o[4 * g4 + 1] * rstd * gg[1] * siluf(bfhi(gw.x))); w.y = cvt_pk_bf16(o[4 * g4 + 2] * rstd * gg[2] * siluf(bflo(gw.y)), o[4 * g4 + 3] * rstd * gg[3] * siluf(bfhi(gw.y)));
        if (Y) *(u32x2*)(Y + tok * NPW + PVD + h * 64 + dv) = w; }
    }
  }
  __syncthreads();
}

#ifdef DBG
#define SEL4(k, a, b, c, d) ((k) == 0 ? (a) : (k) == 1 ? (b) : (k) == 2 ? (c) : (d))
constexpr size_t WS_DBG = WS_END;
__device__ __forceinline__ float bsum(float v, float* red, int tid) {
  __syncthreads(); red[tid] = v; __syncthreads();
  for (int s = 256; s > 0; s >>= 1) { if (tid < s) red[tid] += red[tid + s]; __syncthreads(); }
  const float r = red[0]; __syncthreads(); return r;
}
__device__ __forceinline__ float bmax(float v, float* red, int tid) {
  __syncthreads(); red[tid] = v; __syncthreads();
  for (int s = 256; s > 0; s >>= 1) { if (tid < s) red[tid] = fmaxf(red[tid], red[tid + s]); __syncthreads(); }
  const float r = red[0]; __syncthreads(); return r;
}
__device__ __forceinline__ void dbg_expect(const Params& p, const bf16_t* P, const float* aFB, float* dbg, unsigned char* lds) {
  const int tid = otid(); float* red = (float*)lds; float* Sm = (float*)(lds + 4096);
  const int i = obid(); if (i >= 28) return;
  const int cat = i >> 2, k = i & 3; float* ex = dbg + i * 64;
  const int layer = 0;
  if (cat == 0) {
    const int bs_ = SEL4(k, 0, 7, 19, 31), ss_ = SEL4(k, 0, 100, 255, 37), ds_ = SEL4(k, 0, 17, 63, 40);
    const int b = bs_, s = ss_, h = k, d = ds_; const size_t t = (size_t)b * 256 + s;
    float sc = -1e30f, vv = 0.f;
    if (tid < 256) { const size_t kt = (size_t)b * 256 + tid; float a = 0.f; for (int dd = 0; dd < 64; ++dd) a += bf2f(P[t * NPW + PQ + h * 64 + dd]) * bf2f(P[kt * NPW + PKA + h * 64 + dd]); sc = a; vv = bf2f(P[kt * NPW + PVA + h * 64 + d]); }
    const float m = bmax(sc, red, tid); const float pe = tid < 256 ? __expf(sc - m) : 0.f;
    const float l = bsum(pe, red, tid), o = bsum(pe * vv, red, tid);
    if (tid == 0) ex[0] = o / l * bf2f(P[t * NPW + PGA + h * 64 + d]);
  } else if (cat == 1) {
    const int rs4_ = SEL4(k, 0, 5, 63, 30), cs4_ = SEL4(k, 0, 63, 10, 33), ds_ = SEL4(k, 5, 60, 31, 0);
    const int b = k, r = rs4_, qc = cs4_, h = 3 - k, d = ds_; const size_t rb = (size_t)NCTXR + (size_t)b * 4096; const size_t t = rb + r * 64 + qc;
    const int rs = min(max(r - 4, 0), 56), cs = min(max(qc - 8, 0), 48);
    const int wi = tid >> 6, kc = tid & 63; const size_t kt = rb + (size_t)(rs + wi) * 64 + kc;
    float s1 = -1e30f, v1 = 0.f;
    if (kc >= cs && kc < cs + 16) { float a = 0.f; for (int dd = 0; dd < 64; ++dd) a += bf2f(P[t * NPW + PQ + h * 64 + dd]) * bf2f(P[kt * NPW + PKA + h * 64 + dd]);
      const int dr = rs + wi - r + 7, dc = min(max(kc - qc + 15, 0), 30); s1 = a + p.in[I_RPB][(((size_t)layer * 4 + h) * 15 + dr) * 31 + dc]; v1 = bf2f(P[kt * NPW + PVA + h * 64 + d]); }
    const size_t cb = ((((size_t)b * 4 + layer) * 4 + h) * 512 + tid) * 64;
    float s2 = 0.f; for (int dd = 0; dd < 64; ++dd) s2 += bf2f(P[t * NPW + PQ + h * 64 + dd]) * p.in[I_CK][cb + dd];
    const float v2 = p.in[I_CV][cb + d];
    const float m = bmax(fmaxf(s1, s2), red, tid); const float p1 = __expf(s1 - m), p2 = __expf(s2 - m);
    const float l = bsum(p1 + p2, red, tid), o = bsum(p1 * v1 + p2 * v2, red, tid);
    if (tid == 0) ex[0] = o / l * bf2f(P[t * NPW + PGA + h * 64 + d]);
  } else if (cat == 2 || cat == 3) {
    const bool den = cat == 3;
    const int bc_ = SEL4(k, 1, 30, 12, 5), kc4_ = SEL4(k, 0, 255, 77, 128), jc_ = SEL4(k, 0, 63, 21, 32), kd4_ = SEL4(k, 0, 4095, 1234, 2048), jd_ = SEL4(k, 1, 62, 33, 0);
    const int b = den ? k : bc_, kp = den ? kd4_ : kc4_, g = den ? 3 - k : k, j = den ? jd_ : jc_; const int S = den ? 4096 : 256;
    const size_t rb = den ? (size_t)NCTXR + (size_t)b * 4096 : (size_t)b * 256;
    float a = 0.f;
    for (int s = tid; s < S; s += NTHREADS) for (int c = 0; c < 64; ++c) { const float fr = (float)((kp * s) % S) / (float)S + (float)((j * c) & 63) / 64.f; a += bf2f(P[(rb + s) * NPW + PUC + g * 64 + c]) * cosf(6.283185307179586f * fr); }
    const float tot = bsum(a, red, tid);
    if (tid == 0) ex[0] = tot / sqrtf(64.f * S) * bf2f(P[(rb + kp) * NPW + PGC + g * 64 + j]);
    if (!den) { const int ka = kp & 3, s2 = (kp * 7 + 3) & 63; float tr = 0.f, ti = 0.f;
      if (tid < 256) { const int s1 = tid >> 6, c = tid & 63; const float ph = 6.283185307179586f * ((float)((ka * s1) & 3) * 0.25f + (float)((j * c) & 63) / 64.f + (float)((ka * s2) & 255) / 256.f);
        const float uu = bf2f(P[(rb + s1 * 64 + s2) * NPW + PUC + g * 64 + c]); tr = uu * cosf(ph); ti = -uu * sinf(ph); }
      const float sr = bsum(tr, red, tid), si = bsum(ti, red, tid);
      if (tid == 0) { ex[1] = sr / 128.f; ex[2] = si / 128.f; }
      for (int hyp = 1; hyp <= 6; ++hyp) { float hr = 0.f, hi2 = 0.f;
        if (tid < 256) { const int s1 = tid >> 6, c = tid & 63;
          float p1 = (float)((ka * s1) & 3) * 0.25f, p3 = (float)((ka * s2) & 255) / 256.f; const float p2 = (float)((j * c) & 63) / 64.f;
          if (hyp == 1) p3 = 0.f; if (hyp == 2 || hyp == 6) p1 = (float)((ka * s1) & 63) / 64.f; if (hyp == 3 || hyp == 6) p3 = (float)((ka * s2) & 4095) / 4096.f;
          const float ph = 6.283185307179586f * (p1 + p2 + p3); float uu = bf2f(P[(rb + s1 * 64 + s2) * NPW + PUC + g * 64 + c]);
          if (hyp == 4 && s1 > 0) uu = 0.f; if (hyp == 5) uu = 0.f;
          hr = uu * cosf(ph); hi2 = -uu * sinf(ph); }
        const float r1 = bsum(hr, red, tid), r2 = bsum(hi2, red, tid);
        if (tid == 0) { ex[2 * hyp + 1] = r1 / 128.f; ex[2 * hyp + 2] = r2 / 128.f; } } }
  } else if (cat == 4 || cat == 5) {
    const bool den = cat == 5;
    const int bc_ = SEL4(k, 2, 29, 15, 8), tc_ = SEL4(k, 0, 255, 64, 130), td_ = SEL4(k, 0, 4095, 63, 2100);
    const int b = den ? k : bc_, t = den ? td_ : tc_, h = den ? 3 - k : k; const int S = den ? 4096 : 256;
    const size_t rb = den ? (size_t)NCTXR + (size_t)b * 4096 : (size_t)b * 256;
    const int dk = tid >> 3, dv0 = (tid & 7) * 8;
    float osum = 0.f;
    for (int dir = 0; dir < 2; ++dir) {
      float St[8];
#pragma unroll
      for (int q = 0; q < 8; ++q) St[q] = den ? p.in[I_SG][(((((size_t)b * 4 + layer) * 2 + dir) * 4 + h) * 64 + dk) * 64 + dv0 + q] : 0.f;
      const float* up = p.in[dir ? I_UPB : I_UPF] + (size_t)layer * 16 * 256 + h * 64 + dk; const float bias = p.in[dir ? I_BB : I_BF][layer * 256 + h * 64 + dk];
      const int u0 = dir ? S - 1 : 0, du = dir ? -1 : 1; const int nsteps = dir ? S - t : t + 1;
      for (int st = 0; st < nsteps; ++st) { const int u = u0 + du * st; const size_t tok = rb + u;
        float z = bias; for (int q = 0; q < 16; ++q) z += aFB[tok * 32 + dir * 16 + q] * up[q * 256];
        const float a = __expf(logsigf(z) * (1.f / 16.f)); const float kk = bf2f(P[tok * NPW + PKD + h * 64 + dk]);
#pragma unroll
        for (int q = 0; q < 8; ++q) St[q] = a * St[q] + kk * bf2f(P[tok * NPW + PVD + h * 64 + dv0 + q]); }
      const float qq = bf2f(P[(rb + t) * NPW + PQD + h * 64 + dk]);
      __syncthreads();
#pragma unroll
      for (int q = 0; q < 8; ++q) Sm[dk * 64 + dv0 + q] = qq * St[q];
      __syncthreads();
      if (tid < 64) { float s = 0.f; for (int d2 = 0; d2 < 64; ++d2) s += Sm[d2 * 64 + tid]; osum += s; }
      __syncthreads();
    }
    float o = osum;
    const float ss = bsum(tid < 64 ? o * o : 0.f, red, tid);
    if (tid < 64) ex[tid] = o * rsqrtf(ss / 64.f + 1e-6f) * p.in[I_GN][layer * 64 + tid] * bf2f(P[(rb + t) * NPW + PGD + h * 64 + tid]);
  } else if (cat == 6) {
    const int rows_ = SEL4(k, 0, 255, 8192, 24575), chs_ = SEL4(k, 0, 100, 255, 7);
    const int row = rows_, ch = chs_; int s, S; if (row < NCTXR) { s = row & 255; S = 256; } else { s = (row - NCTXR) & 4095; S = 4096; }
    if (tid == 0) { float cv = 0.f; for (int d = 0; d < 3; ++d) { const int sd = s + d - 1; if (sd >= 0 && sd < S) { const size_t r2 = (size_t)row + d - 1; cv += bf2f(P[r2 * NPW + PCB + ch]) * bf2f(P[r2 * NPW + PHB + ch]) * p.in[I_CONV][layer * 768 + d * 256 + ch]; } }
      ex[0] = bf2f(P[(size_t)row * NPW + PBB + ch]) * cv * bf2f(P[(size_t)row * NPW + PGB + ch]); }
  }
}
__device__ __forceinline__ void dbg_compare(const bf16_t* P, float* dbg, const bf16_t* Zr, const bf16_t* Zi) {
  if (obid() != 0 || otid() != 0) return;
  int mask = 0, fine = 0, hypm = 0;
  for (int i = 0; i < 28; ++i) { const int cat = i >> 2, k = i & 3; const float* ex = dbg + i * 64; bool bad = false;
    if (cat == 0) { const int bs_ = SEL4(k, 0, 7, 19, 31), ss_ = SEL4(k, 0, 100, 255, 37), ds_ = SEL4(k, 0, 17, 63, 40); const size_t t = (size_t)bs_ * 256 + ss_;
      const float a = bf2f(P[t * NPW + PQ + k * 64 + ds_]); bad = !(fabsf(a - ex[0]) <= 0.01f + 0.03f * fabsf(ex[0])); }
    else if (cat == 1) { const int rs4_ = SEL4(k, 0, 5, 63, 30), cs4_ = SEL4(k, 0, 63, 10, 33), ds_ = SEL4(k, 5, 60, 31, 0); const size_t t = (size_t)NCTXR + (size_t)k * 4096 + rs4_ * 64 + cs4_;
      const float a = bf2f(P[t * NPW + PQ + (3 - k) * 64 + ds_]); bad = !(fabsf(a - ex[0]) <= 0.01f + 0.03f * fabsf(ex[0])); }
    else if (cat == 2) { const int bc_ = SEL4(k, 1, 30, 12, 5), kc4_ = SEL4(k, 0, 255, 77, 128), jc_ = SEL4(k, 0, 63, 21, 32); const size_t t = (size_t)bc_ * 256 + kc4_;
      const float a = bf2f(P[t * NPW + PUC + k * 64 + jc_]); bad = !(fabsf(a - ex[0]) <= 0.01f + 0.03f * fabsf(ex[0]));
      if (bad) fine |= (1 << k);
      const int ka = kc4_ & 3, s2 = (kc4_ * 7 + 3) & 63; const size_t zo = (((size_t)(bc_ * 4 + k) * 4 + ka) * 64 + jc_) * 64 + s2;
      const float zr = bf2f(Zr[zo]), zi = bf2f(Zi[zo]);
      if (k == 1) { for (int hyp = 1; hyp <= 6; ++hyp) if ((fabsf(zr - ex[2 * hyp + 1]) <= 0.01f + 0.03f * fabsf(ex[2 * hyp + 1])) && (fabsf(zi - ex[2 * hyp + 2]) <= 0.01f + 0.03f * fabsf(ex[2 * hyp + 2]))) hypm |= (1 << (hyp - 1)); } }
    else if (cat == 3) { const int kd4_ = SEL4(k, 0, 4095, 1234, 2048), jd_ = SEL4(k, 1, 62, 33, 0); const size_t t = (size_t)NCTXR + (size_t)k * 4096 + kd4_;
      const float a = bf2f(P[t * NPW + PUC + (3 - k) * 64 + jd_]); bad = !(fabsf(a - ex[0]) <= 0.01f + 0.03f * fabsf(ex[0])); }
    else if (cat == 4 || cat == 5) { const bool den = cat == 5; const int bc_ = SEL4(k, 2, 29, 15, 8), tc_ = SEL4(k, 0, 255, 64, 130), td_ = SEL4(k, 0, 4095, 63, 2100);
      const size_t t = den ? (size_t)NCTXR + (size_t)k * 4096 + td_ : (size_t)bc_ * 256 + tc_; const int h = den ? 3 - k : k;
      for (int d = 0; d < 64; ++d) { const float a = bf2f(P[t * NPW + PVD + h * 64 + d]); if (!(fabsf(a - ex[d]) <= 0.01f + 0.03f * fabsf(ex[d]))) bad = true; } }
    else { const int rows_ = SEL4(k, 0, 255, 8192, 24575), chs_ = SEL4(k, 0, 100, 255, 7);
      const float a = bf2f(P[(size_t)rows_ * NPW + PBB + chs_]); bad = !(fabsf(a - ex[0]) <= 0.01f + 0.03f * fabsf(ex[0])); }
    if (bad) mask |= (1 << cat);
  }
  dbg[32 * 64] = (float)((mask & 63) ? (mask & 63) : (mask >> 6) * 64); (void)fine; (void)hypm;
}
#endif
__global__ void __launch_bounds__(NTHREADS) fwd_megakernel(Params p) {
  const int tidx_ = otid(), bidx_ = obid(), gdim_ = ogdim(); (void)tidx_; (void)bidx_; (void)gdim_;
  extern __shared__ __attribute__((aligned(16))) unsigned char lds[];
  cg::grid_group grid = cg::this_grid();
  volatile LAS unsigned* bst = (volatile LAS unsigned*)((LAS unsigned char*)lds + (LDS_BYTES - 16));
  if (threadIdx.x == 0) { bst[0] = 0u; bst[1] = 0u; }
  __syncthreads();
  const XcdBarrier xb = xcd_barrier_post((unsigned*)(p.ws + WS_BAR), bst);
  unsigned char* ws = p.ws;
  bf16_t* P = (bf16_t*)(ws + WS_P); bf16_t* hN = (bf16_t*)(ws + WS_R);
  bf16_t* Zr = (bf16_t*)(ws + WS_R); bf16_t* Zi = (bf16_t*)(ws + WS_R + R_ZI); bf16_t* ST = (bf16_t*)(ws + WS_R + R_ST);
  bf16_t* WinT0 = (bf16_t*)(ws + WS_WIN); bf16_t* WaT0 = (bf16_t*)(ws + WS_WA); bf16_t* WoutT0 = (bf16_t*)(ws + WS_WOUT);
  float* mod = (float*)(ws + WS_MOD); float* aFB = (float*)(ws + WS_AFB); float* DEC = (float*)(ws + WS_DEC);
  LAS unsigned char* ldsl = (LAS unsigned char*)lds;
  bf16_t* DRY = nullptr; asm volatile("" : "+s"(DRY)); (void)DRY;

  phase_mod(p, (float*)(ws + WS_P), lds);
  phase_wconv(p, 0, WinT0, WaT0, WoutT0, lds, 0, gdim_);
  phase_cachecvt(p, (bf16_t*)(ws + WS_CKB), (bf16_t*)(ws + WS_CVB));
  if (p.ws == nullptr) grid.sync();
  xcd_barrier(xb);
  phase_mod_reduce(p, (const float*)(ws + WS_P), mod);
  xcd_barrier(xb);
  for (int layer = 0; layer < 4; ++layer) {
    const float* mod_l = mod + (size_t)layer * 5 * 3072;
    const int par = layer & 1;
    bf16_t* WinT = WinT0 + (size_t)par * NPW * DM; bf16_t* WaT = WaT0 + (size_t)par * 32 * DM; bf16_t* WoutT = WoutT0 + (size_t)par * DM * DM;
#if PROBE == 6
    phase_norm(p, layer, mod_l, hN, WinT, WaT, WoutT, lds);
#endif
    phase_norm(p, layer, mod_l, hN, WinT, WaT, WoutT, lds);
    xcd_barrier(xb);
    {
      pg8::Gemm g{hN, WinT, MROWS, NPW, DM, DM};
      pg8::StaticOrder S; S.init(MROWS, NPW, gdim_, bidx_);
      EpiIn E{P, p.in[I_QG] + layer * 64, p.in[I_KG] + layer * 64, p.out + OFF_CK, p.out + OFF_CV, layer};
#if PROBE == 5
      pg8::gemm_phase<EpiIn>(ldsl, g, S, E);
      phase_afb(hN, WaT, aFB);
#endif
      pg8::gemm_phase<EpiIn>(ldsl, g, S, E);
      phase_afb(hN, WaT, aFB);
    }
    xcd_barrier(xb);
#ifdef DBG
    if (layer == 0) { dbg_expect(p, P, aFB, (float*)(ws + WS_DBG), lds); __syncthreads(); }
#endif
#if PROBE == 1
    attn_den(p, layer, P, DRY, lds);
#endif
    attn_den(p, layer, P, P, lds);
#if PROBE == 8
    attn_ctx(P, DRY, lds); conv_mix(p, layer, P, DRY);
#endif
    attn_ctx(P, P, lds);
    conv_mix(p, layer, P, P);
#if PROBE == 3
    fourier1(P, Zr, Zi, lds);
#endif
    fourier1(P, Zr, Zi, lds);
#if PROBE == 4
    gla1(p, layer, P, aFB, ST, DEC, lds);
#endif
    gla1(p, layer, P, aFB, ST, DEC, lds);
    xcd_barrier(xb);
#if PROBE == 10
    fourier2(P, Zr, Zi, lds);
#endif
    fourier2(P, Zr, Zi, lds);
    gla2(p, layer, ST, DEC);
    xcd_barrier(xb);
#if PROBE == 2
    gla3(p, layer, P, DRY, aFB, ST, lds);
#endif
    gla3(p, layer, P, P, aFB, ST, lds);
    xcd_barrier(xb);
#if PROBE == 7
    for (int i = 0; i < 6; ++i) xcd_barrier(xb);
#endif
#ifdef DBG
    if (layer == 0) dbg_compare(P, (float*)(ws + WS_DBG), Zr, Zi);
#endif
    {
      pg8::Gemm g{P, WoutT, MROWS, DM, DM, NPW};
      pg8::StaticOrder S; S.init(MROWS, DM, gdim_, bidx_);
#if PROBE == 9
      { EpiOut E0{layer == 0 ? p.in[I_XP] : nullptr, p.in[I_XS], p.out, mod_l, (float*)DRY}; pg8::gemm_phase<EpiOut>(ldsl, g, S, E0); }
#endif
      EpiOut E{layer == 0 ? p.in[I_XP] : nullptr, p.in[I_XS], p.out, mod_l, p.out};
      pg8::gemm_phase<EpiOut>(ldsl, g, S, E);
      if (layer < 3) { const int np = par ^ 1; const int b0 = (gdim_ == 256) ? 128 : 0;
        phase_wconv(p, layer + 1, WinT0 + (size_t)np * NPW * DM, WaT0 + (size_t)np * 32 * DM, WoutT0 + (size_t)np * DM * DM, lds, b0, gdim_ - b0); }
    }
    xcd_barrier(xb);
  }
#ifdef DBG
  if (obid() == 0 && otid() == 0) p.out[0] += 10000.f * ((float*)(ws + WS_DBG))[32 * 64];
#endif
}

extern "C" void kernel_launch(void* const* d_in, const int* in_sizes, int n_in, void* d_out, int out_size,
                              void* d_ws, size_t ws_size, hipStream_t stream) {
  static int grid_blocks = 0;
  if (!grid_blocks) {
    int dev = 0, cus = 0;
    (void)hipGetDevice(&dev);
    (void)hipDeviceGetAttribute(&cus, hipDeviceAttributeMultiprocessorCount, dev);
    (void)hipFuncSetAttribute((const void*)fwd_megakernel, hipFuncAttributeMaxDynamicSharedMemorySize, LDS_BYTES);
    grid_blocks = cus > 0 ? cus : 256;
    if (ws_size < WS_END) fprintf(stderr, "workspace too small: %zu < %zu\n", ws_size, (size_t)WS_END);
  }
  (void)hipMemsetAsync((unsigned char*)d_ws + WS_BAR, 0, (size_t)XCD_BAR_WORDS * 4, stream);
  Params p{};
  for (int i = 0; i < 21; ++i) p.in[i] = (const float*)d_in[i];
  p.out = (float*)d_out;
  p.ws = (unsigned char*)d_ws;
  void* args[] = {&p};
  hipError_t e = hipLaunchCooperativeKernel((void*)fwd_megakernel, dim3(grid_blocks), dim3(NTHREADS), args, LDS_BYTES, stream);
  if (e != hipSuccess) fprintf(stderr, "cooperative launch failed: %s (grid %d)\n", hipGetErrorString(e), grid_blocks);
}
```

```cpp
#ifndef PROBE
#define PROBE 0
#endif
#include <hip/hip_runtime.h>
#include <hip/hip_cooperative_groups.h>
#include <cstdio>
#include <cstdint>
namespace cg = cooperative_groups;

#define LAS __attribute__((address_space(3)))
typedef unsigned short bf16_t;
typedef short bf16x8 __attribute__((ext_vector_type(8)));
typedef short bf16x4 __attribute__((ext_vector_type(4)));
typedef float f32x4 __attribute__((ext_vector_type(4)));
typedef float f32x16 __attribute__((ext_vector_type(16)));
typedef unsigned u32x4 __attribute__((ext_vector_type(4)));
typedef unsigned u32x2 __attribute__((ext_vector_type(2)));

constexpr int DM = 1024, NCTXR = 8192, NDENR = 16384, MROWS = 24576, NPW = 3584, NIN = 3616;
constexpr int NTHREADS = 512;
constexpr int LDS_BYTES = 147456;
constexpr int PQ = 0, PBB = 256, PUC = 512, PVD = 768, PKA = 1024, PVA = 1280, PGA = 1536, PCB = 1792, PHB = 2048, PGB = 2304, PGC = 2560, PQD = 2816, PKD = 3072, PGD = 3328;
constexpr long long OFF_YP = 0, OFF_CK = 25165824LL, OFF_CV = 33554432LL, OFF_ST = 41943040LL;
constexpr size_t WS_P = 0;
constexpr size_t WS_R = WS_P + (size_t)MROWS * NPW * 2;
constexpr size_t WS_WIN = WS_R + (size_t)MROWS * DM * 2;
constexpr size_t WS_WA = WS_WIN + (size_t)2 * NPW * DM * 2;
constexpr size_t WS_WOUT = WS_WA + (size_t)2 * 32 * DM * 2;
constexpr size_t WS_MOD = WS_WOUT + (size_t)2 * DM * DM * 2;
constexpr size_t WS_AFB = WS_MOD + (size_t)4 * 5 * 3072 * 4;
constexpr size_t WS_DEC = WS_AFB + (size_t)MROWS * 32 * 4;
constexpr size_t WS_CKB = WS_DEC + (size_t)3072 * 64 * 4;
constexpr size_t WS_CVB = WS_CKB + (size_t)2097152 * 2;
constexpr size_t WS_BAR = WS_CVB + (size_t)2097152 * 2;
constexpr size_t WS_END = WS_BAR + (size_t)16384;
constexpr size_t R_ZI = 12582912, R_ST = 25165824;

struct Params {
  const float* in[21];
  float* out;
  unsigned char* ws;
};
enum { I_XP = 0, I_XS, I_CK, I_CV, I_SG, I_C, I_CCTX, I_NG, I_WMOD, I_BMOD, I_WIN, I_QG, I_KG, I_RPB, I_CONV, I_UPF, I_BF, I_UPB, I_BB, I_GN, I_WOUT };

typedef __bf16 bf16v2_t __attribute__((ext_vector_type(2)));
typedef float f32v2_t __attribute__((ext_vector_type(2)));
__device__ __forceinline__ unsigned cvt_pk_bf16(float lo, float hi) { f32v2_t v = {lo, hi}; bf16v2_t b = __builtin_convertvector(v, bf16v2_t); return __builtin_bit_cast(unsigned, b); }
__device__ __forceinline__ float bf2f(unsigned short h) { return __uint_as_float(((unsigned)h) << 16); }
__device__ __forceinline__ float bflo(unsigned w) { return __uint_as_float(w << 16); }
__device__ __forceinline__ float bfhi(unsigned w) { return __uint_as_float(w & 0xffff0000u); }
__device__ __forceinline__ unsigned short f2bf(float f) { return (unsigned short)(cvt_pk_bf16(f, 0.f) & 0xffffu); }
__device__ __forceinline__ float siluf(float x) { return x / (1.f + __expf(-x)); }
__device__ __forceinline__ float logsigf(float z) { return fminf(z, 0.f) - __logf(1.f + __expf(-fabsf(z))); }
__device__ __forceinline__ bf16x8 as_bf16x8(u32x4 v) { return __builtin_bit_cast(bf16x8, v); }
__device__ __forceinline__ f32x16 mfma32(bf16x8 a, bf16x8 b, f32x16 c) { return __builtin_amdgcn_mfma_f32_32x32x16_bf16(a, b, c, 0, 0, 0); }
__device__ __forceinline__ f32x16 zero16() { f32x16 z;
#pragma unroll
  for (int i = 0; i < 16; ++i) z[i] = 0.f; return z; }
__device__ __forceinline__ bf16x8 pack8(const f32x16& a, int s) {
  u32x4 w; w.x = cvt_pk_bf16(a[8 * s + 0], a[8 * s + 1]); w.y = cvt_pk_bf16(a[8 * s + 2], a[8 * s + 3]); w.z = cvt_pk_bf16(a[8 * s + 4], a[8 * s + 5]); w.w = cvt_pk_bf16(a[8 * s + 6], a[8 * s + 7]);
  return as_bf16x8(w);
}
__device__ __forceinline__ bf16x8 ld_frag16(const void* p) { return as_bf16x8(*(const u32x4*)p); }
__device__ __forceinline__ bf16x8 ld_frag8x2(const void* lo, const void* hi) { u32x2 a = *(const u32x2*)lo, b = *(const u32x2*)hi; u32x4 w; w.x = a.x; w.y = a.y; w.z = b.x; w.w = b.y; return as_bf16x8(w); }
__device__ __forceinline__ bf16x8 ld_f32x8_as_bf16(const float* p) { f32x4 a = *(const f32x4*)p, b = *(const f32x4*)(p + 4); u32x4 w; w.x = cvt_pk_bf16(a[0], a[1]); w.y = cvt_pk_bf16(a[2], a[3]); w.z = cvt_pk_bf16(b[0], b[1]); w.w = cvt_pk_bf16(b[2], b[3]); return as_bf16x8(w); }

__device__ __forceinline__ int row_vec(int row) { return row < NCTXR ? 0 : 1 + ((row - NCTXR) >> 12); }

__device__ __forceinline__ int otid() { int t = threadIdx.x; asm volatile("" : "+v"(t)); return t; }
__device__ __forceinline__ int obid() { int t = blockIdx.x; asm volatile("" : "+s"(t)); return t; }
__device__ __forceinline__ int ogdim() { int t = gridDim.x; asm volatile("" : "+s"(t)); return t; }


#define XB_TMO      128
#define XB_XCNT(j)  (256  + 64 * (j))
#define XB_XSUB(j)  (1280 + 64 * (j))
#define XB_XGEN(j)  (2304 + 64 * (j))
#define XB_TOP      3328
#define XB_TOPGEN   3392
#define XCD_BAR_WORDS 3456
#define XB_SPIN_CAP (1u << 18)
__device__ __forceinline__ unsigned xb_ld(unsigned* p)              { return __hip_atomic_load(p, __ATOMIC_RELAXED, __HIP_MEMORY_SCOPE_AGENT); }
__device__ __forceinline__ unsigned xb_add(unsigned* p, unsigned v) { return __hip_atomic_fetch_add(p, v, __ATOMIC_RELAXED, __HIP_MEMORY_SCOPE_AGENT); }
__device__ __forceinline__ unsigned xb_xcc_id() { return (unsigned)__builtin_amdgcn_s_getreg((3 << 11) | 20) & 0xFu; }
#define XB_SPIN(cond, bar) do { unsigned _sp = 0; while (cond) { __builtin_amdgcn_s_sleep(1); \
    if ((++_sp & 255u) == 0u) { if (xb_ld(&(bar)[XB_TMO])) break; if (_sp > XB_SPIN_CAP) { atomicAdd(&(bar)[XB_TMO], 1u); break; } } } } while (0)
struct XcdBarrier { unsigned* bar; unsigned x; volatile LAS unsigned* st; };
__device__ __forceinline__ XcdBarrier xcd_barrier_post(unsigned* bar, volatile LAS unsigned* st) {
  XcdBarrier b; b.bar = bar; b.x = xb_xcc_id(); b.st = st;
  if (threadIdx.x == 0) (void)xb_add(&bar[XB_XCNT(b.x)], 1u);
  return b;
}
__device__ __forceinline__ void xcd_barrier_complete(unsigned* bar, unsigned x, unsigned& nloc, unsigned& nx) {
  const unsigned G = gridDim.x * gridDim.y * gridDim.z;
  unsigned sum, cnt, mine, sp = 0u;
  for (;;) {
    sum = 0u; cnt = 0u; mine = 0u;
#pragma unroll
    for (unsigned j = 0; j < 16; ++j) { const unsigned c = xb_ld(&bar[XB_XCNT(j)]); sum += c; cnt += (c > 0u) ? 1u : 0u; mine = (j == x) ? c : mine; }
    if (sum == G) break;
    __builtin_amdgcn_s_sleep(1);
    if ((++sp & 255u) == 0u) { if (xb_ld(&bar[XB_TMO])) break; if (sp > XB_SPIN_CAP) { atomicAdd(&bar[XB_TMO], 1u); break; } }
  }
  nloc = mine > 0u ? mine : 1u; nx = cnt > 0u ? cnt : 1u;
}
__device__ __forceinline__ void xcd_barrier(const XcdBarrier& b) {
  asm volatile("s_waitcnt vmcnt(0)" ::: "memory");
  __syncthreads();
  if (threadIdx.x == 0) {
    unsigned* bar = b.bar;
    __builtin_amdgcn_s_waitcnt(0);
    unsigned nloc = b.st[0], nx = b.st[1];
    if (nloc == 0u) { xcd_barrier_complete(bar, b.x, nloc, nx); b.st[0] = nloc; b.st[1] = nx; }
    const unsigned old = xb_add(&bar[XB_XSUB(b.x)], 1u);
    const unsigned gen = old / nloc;
    if (old + 1u == (gen + 1u) * nloc) {
      __builtin_amdgcn_fence(__ATOMIC_RELEASE, "agent");
      asm volatile("s_waitcnt vmcnt(0)" ::: "memory");
      const unsigned og = xb_add(&bar[XB_TOP], 1u);
      const unsigned tg = og / nx;
      if (og + 1u == (tg + 1u) * nx) xb_add(&bar[XB_TOPGEN], 1u);
      else XB_SPIN(xb_ld(&bar[XB_TOPGEN]) == tg, bar);
      __builtin_amdgcn_fence(__ATOMIC_ACQUIRE, "agent");
      xb_add(&bar[XB_XGEN(b.x)], 1u);
      asm volatile("s_waitcnt vmcnt(0)" ::: "memory");
    } else {
      XB_SPIN(xb_ld(&bar[XB_XGEN(b.x)]) == gen, bar);
      __builtin_amdgcn_fence(__ATOMIC_ACQUIRE, "agent");
      asm volatile("s_waitcnt vmcnt(0)" ::: "memory");
    }
  }
  __syncthreads();
}

namespace pg8 {
constexpr int BM = 256, BK = 64, HALF = 128, HTB = HALF * BK * 2, NXCD = 8, WGM = 8;
__host__ __device__ __forceinline__ int lds_byte(int r, int c) { const int st = (r >> 4) * 2 + (c >> 5), rr = r & 15, cc = c & 31, ob = rr * 64 + cc * 2; return st * 1024 + (ob ^ (((ob >> 9) & 1) << 5)); }
__host__ __device__ __forceinline__ void stage_rc(int b, int& R, int& C) { const int st = b / 1024, sb = b % 1024, swz = sb ^ (((sb >> 9) & 1) << 5); R = (st >> 1) * 16 + swz / 64; C = (st & 1) * 32 + (swz % 64) / 2; }
struct Unit { int pm, pn; };
struct Gemm { const bf16_t* A; const bf16_t* Bt; int M, N, K, lda; };
struct StaticOrder {
  int nM, nN, nwg, G, c;
  __device__ void init(int M, int N, int G_, int c_) { nM = M / BM; nN = N / BM; nwg = nM * nN; G = G_; c = c_; }
  __device__ bool next(int i, Unit& u) const {
    const long L = (long)i * G + c; if (L >= nwg) return false;
    int wgid = (int)L; { const int q = nwg / NXCD, r = nwg % NXCD, xcd = wgid % NXCD, off = wgid / NXCD; wgid = (xcd < r ? xcd * (q + 1) : r * (q + 1) + (xcd - r) * q) + off; }
    const int nig = WGM * nN, gid = wgid / nig, fm = gid * WGM, gsz = (nM - fm) < WGM ? (nM - fm) : WGM;
    u.pm = fm + ((wgid % nig) % gsz); u.pn = (wgid % nig) / gsz; return true;
  }
};
template <class Epi>
__device__ __forceinline__ void gemm_phase(LAS unsigned char* lds, const Gemm g, const StaticOrder& S, const Epi& E) {
  const int tidx_ = otid(), bidx_ = obid(), gdim_ = ogdim(); (void)tidx_; (void)bidx_; (void)gdim_;
  const int tid = tidx_, wid = __builtin_amdgcn_readfirstlane(tid >> 6), lane = tid & 63, wr = wid >> 2, wc = wid & 3, fr = lane & 15, fq = lane >> 4;
  const int K = g.K, nt = K / BK, lda = g.lda;
  unsigned voffA[2], voffB[2];
#pragma unroll
  for (int i = 0; i < 2; ++i) { int R, C; stage_rc(tid * 16 + i * 8192, R, C); voffA[i] = (unsigned)(R * lda + C) * 2u; voffB[i] = (unsigned)(R * K + C) * 2u; }
  const size_t kstep = (size_t)(BK * 2);
  const size_t hstepA = (size_t)HALF * lda * 2, hstepB = (size_t)HALF * K * 2;
  const size_t tstepA = 2 * hstepA, tstepB = 2 * hstepB;
  const unsigned ldsw = (unsigned)wid * 1024u;
  const int aoff = lds_byte(wr * 64 + fr, fq * 8), boff = lds_byte(wc * 32 + fr, fq * 8);
#define PG8_SA(b, h) (((b) * 2 + (h)) * HTB)
#define PG8_SB(b, h) ((4 + (b) * 2 + (h)) * HTB)
#define PG8_STAGE(bufoff, gbase, voff) do { _Pragma("unroll") for (int _i = 0; _i < 2; ++_i) \
    __builtin_amdgcn_global_load_lds((const unsigned*)((const char*)(gbase) + (voff)[_i]), (LAS unsigned*)(lds + (bufoff) + ldsw + _i * 8192), 16, 0, 0); } while (0)
#define PG8_LDA(dst, b, h) do { _Pragma("unroll") for (int m = 0; m < 4; ++m) _Pragma("unroll") for (int k = 0; k < 2; ++k) dst[m][k] = *(const LAS bf16x8*)(lds + PG8_SA(b, h) + aoff + m * 2048 + k * 1024); } while (0)
#define PG8_LDB(dst, b, h) do { _Pragma("unroll") for (int n = 0; n < 2; ++n) _Pragma("unroll") for (int k = 0; k < 2; ++k) dst[n][k] = *(const LAS bf16x8*)(lds + PG8_SB(b, h) + boff + n * 2048 + k * 1024); } while (0)
#define PG8_MMA(ai, bj, At, Bt) do { __builtin_amdgcn_s_setprio(1); _Pragma("unroll") for (int m = 0; m < 4; ++m) _Pragma("unroll") for (int n = 0; n < 2; ++n) _Pragma("unroll") for (int k = 0; k < 2; ++k) \
    acc[ai][bj][m][n] = __builtin_amdgcn_mfma_f32_16x16x32_bf16(Bt[n][k], At[m][k], acc[ai][bj][m][n], 0, 0, 0); __builtin_amdgcn_s_setprio(0); } while (0)
#define PG8_WAIT_V(n) asm volatile("s_waitcnt vmcnt(" #n ")" ::: "memory")
#define PG8_WAIT_L(n) asm volatile("s_waitcnt lgkmcnt(" #n ")" ::: "memory")
#define PG8_BAR __builtin_amdgcn_s_barrier()
#define PG8_SCHED __builtin_amdgcn_sched_barrier(0)
  Unit cur, nxt; int ui = 0;
  if (!S.next(0, cur)) return;
  f32x4 acc[2][2][4][2];
#pragma unroll
  for (int a = 0; a < 2; ++a)
#pragma unroll
    for (int b = 0; b < 2; ++b)
#pragma unroll
      for (int m = 0; m < 4; ++m)
#pragma unroll
        for (int n = 0; n < 2; ++n) acc[a][b][m][n] = (f32x4){0.f, 0.f, 0.f, 0.f};
  bf16x8 At[4][2], B0[2][2], B1[2][2];
  const char* cA = (const char*)g.A + (size_t)cur.pm * tstepA; const char* cB = (const char*)g.Bt + (size_t)cur.pn * tstepB;
  PG8_STAGE(PG8_SB(0, 0), cB, voffB); PG8_STAGE(PG8_SB(0, 1), cB + hstepB, voffB); PG8_STAGE(PG8_SA(0, 0), cA, voffA); PG8_STAGE(PG8_SA(0, 1), cA + hstepA, voffA);
  if (wr == 1) PG8_BAR;
  PG8_WAIT_V(2); PG8_BAR;
  PG8_STAGE(PG8_SB(1, 0), cB + kstep, voffB); PG8_STAGE(PG8_SA(1, 0), cA + kstep, voffA); PG8_STAGE(PG8_SB(1, 1), cB + hstepB + kstep, voffB);
  PG8_WAIT_V(6); PG8_BAR;
  for (;;) {
    const bool has_next = S.next(ui + 1, nxt);
    const char* nA = has_next ? (const char*)g.A + (size_t)nxt.pm * tstepA : cA; const char* nB = has_next ? (const char*)g.Bt + (size_t)nxt.pn * tstepB : cB;
    for (int t = 0; t < nt; t += 2) {
      const bool last = (t == nt - 2);
      const char* a1 = cA + (size_t)(t + 1) * kstep;
      const char* a2 = last ? nA : cA + (size_t)(t + 2) * kstep; const char* b2 = last ? nB : cB + (size_t)(t + 2) * kstep;
      const char* a3 = a2 + kstep; const char* b3 = b2 + kstep;
      PG8_LDB(B0, 0, 0); PG8_LDB(B1, 0, 1); PG8_SCHED; PG8_LDA(At, 0, 0); PG8_STAGE(PG8_SA(1, 1), a1 + hstepA, voffA);
      PG8_WAIT_V(8); PG8_WAIT_L(0); PG8_BAR; PG8_MMA(0, 0, At, B0); PG8_MMA(0, 1, At, B1); PG8_BAR; PG8_SCHED;
      PG8_LDA(At, 0, 1); PG8_STAGE(PG8_SB(0, 0), b2, voffB); PG8_STAGE(PG8_SB(0, 1), b2 + hstepB, voffB); PG8_STAGE(PG8_SA(0, 0), a2, voffA);
      PG8_WAIT_V(8); PG8_WAIT_L(0); PG8_BAR; PG8_MMA(1, 0, At, B0); PG8_MMA(1, 1, At, B1); PG8_BAR; PG8_SCHED;
      PG8_LDB(B0, 1, 0); PG8_LDB(B1, 1, 1); PG8_SCHED; PG8_LDA(At, 1, 0); PG8_STAGE(PG8_SA(0, 1), a2 + hstepA, voffA);
      PG8_WAIT_V(8); PG8_WAIT_L(0); PG8_BAR; PG8_MMA(0, 0, At, B0); PG8_MMA(0, 1, At, B1); PG8_BAR; PG8_SCHED;
      PG8_LDA(At, 1, 1); PG8_STAGE(PG8_SB(1, 0), b3, voffB); PG8_STAGE(PG8_SB(1, 1), b3 + hstepB, voffB); PG8_STAGE(PG8_SA(1, 0), a3, voffA);
      PG8_WAIT_V(8); PG8_WAIT_L(0); PG8_BAR; PG8_MMA(1, 0, At, B0); PG8_MMA(1, 1, At, B1); PG8_BAR; PG8_SCHED;
    }
    if (wr == 0) PG8_BAR;
    E(acc, cur, wr, wc, fr, fq);
    if (!has_next) break;
#pragma unroll
    for (int a = 0; a < 2; ++a)
#pragma unroll
      for (int b = 0; b < 2; ++b)
#pragma unroll
        for (int m = 0; m < 4; ++m)
#pragma unroll
          for (int n = 0; n < 2; ++n) acc[a][b][m][n] = (f32x4){0.f, 0.f, 0.f, 0.f};
    cur = nxt; cA = nA; cB = nB; ++ui;
    if (wr == 1) PG8_BAR;
  }
  PG8_WAIT_V(0);
  PG8_BAR;
#undef PG8_SA
#undef PG8_SB
#undef PG8_STAGE
#undef PG8_LDA
#undef PG8_LDB
#undef PG8_MMA
#undef PG8_WAIT_V
#undef PG8_WAIT_L
#undef PG8_BAR
#undef PG8_SCHED
}
}

struct EpiIn {
  bf16_t* P; const float* qg; const float* kg; float* ck; float* cv; int layer;
  __device__ __forceinline__ void operator()(const f32x4 (&acc)[2][2][4][2], const pg8::Unit& u, int wr, int wc, int fr, int fq) const {
    const int gp = u.pn;
    const int row0 = u.pm * 256 + wr * 64 + fr;
    const int cl = wc * 64 + 8 * fq;
    const bool isq = (gp == 0), isk = (gp == 4), isv = (gp == 5), isqd = (gp == 11);
    const bool ctxrow = u.pm < 32;
#pragma unroll
    for (int ai = 0; ai < 2; ++ai)
#pragma unroll
      for (int m = 0; m < 4; ++m) {
        const int row = row0 + ai * 128 + m * 16;
        float sc = 1.f;
        if (isq || isk) {
          float ss = 0.f;
#pragma unroll
          for (int bj = 0; bj < 2; ++bj)
#pragma unroll
            for (int n = 0; n < 2; ++n) { const f32x4 x = acc[ai][bj][m][n]; ss += (x[0] * x[0] + x[1] * x[1]) + (x[2] * x[2] + x[3] * x[3]); }
          ss += __shfl_xor(ss, 16); ss += __shfl_xor(ss, 32);
          sc = rsqrtf(ss * (1.f / 64.f) + 1e-6f);
          if (isq) sc *= 0.125f;
        }
        if (isqd) sc = 0.125f;
#pragma unroll
        for (int bj = 0; bj < 2; ++bj) {
          f32x4 v0 = acc[ai][bj][m][0] * sc, v1 = acc[ai][bj][m][1] * sc;
          const int c = cl + 32 * bj;
          if (isq || isk) {
            const float* gg = (isq ? qg : kg) + (c & 63);
            const f32x4 g0 = *(const f32x4*)gg, g1 = *(const f32x4*)(gg + 4);
            v0 = v0 * g0; v1 = v1 * g1;
          }
          u32x4 w; w.x = cvt_pk_bf16(v0[0], v0[1]); w.y = cvt_pk_bf16(v0[2], v0[3]); w.z = cvt_pk_bf16(v1[0], v1[1]); w.w = cvt_pk_bf16(v1[2], v1[3]);
          *(u32x4*)(P + (size_t)row * NPW + gp * 256 + c) = w;
          if ((isk || isv) && ctxrow) {
            const int b = row >> 8, s = row & 255, h = c >> 6, d = c & 63;
            float* o = (isk ? ck : cv) + ((((size_t)b * 4 + layer) * 4 + h) * 256 + s) * 64 + d;
            *(f32x4*)o = v0; *(f32x4*)(o + 4) = v1;
          }
        }
      }
  }
};
struct EpiOut {
  const float* xp; const float* xs; float* out; const float* mod; float* dst;
  __device__ __forceinline__ void operator()(const f32x4 (&acc)[2][2][4][2], const pg8::Unit& u, int wr, int wc, int fr, int fq) const {
    const int row0 = u.pm * 256 + wr * 64 + fr;
    const int c0 = u.pn * 256 + wc * 64 + 8 * fq;
    const float* gv = mod + (size_t)row_vec(u.pm * 256) * 3072 + 2048;
    const float* src = xp ? (u.pm < 32 ? xp : xs - (size_t)NCTXR * DM) : out;
#pragma unroll
    for (int bj = 0; bj < 2; ++bj) {
      const int c = c0 + 32 * bj;
      const f32x4 g0 = *(const f32x4*)(gv + c), g1 = *(const f32x4*)(gv + c + 4);
#pragma unroll
      for (int ai = 0; ai < 2; ++ai)
#pragma unroll
        for (int m = 0; m < 4; ++m) {
          const size_t off = (size_t)(row0 + ai * 128 + m * 16) * DM + c;
          const f32x4 x0 = *(const f32x4*)(src + off), x1 = *(const f32x4*)(src + off + 4);
          if (dst) { *(f32x4*)(dst + off) = x0 + g0 * acc[ai][bj][m][0];
            *(f32x4*)(dst + off + 4) = x1 + g1 * acc[ai][bj][m][1]; }
        }
    }
  }
};

__device__ __forceinline__ void phase_mod(const Params& p, float* part, unsigned char* lds) {
  const int tidx_ = otid(), bidx_ = obid(), gdim_ = ogdim(); (void)tidx_; (void)bidx_; (void)gdim_;
  const float* wmod = p.in[I_WMOD]; const float* c = p.in[I_C]; const float* cctx = p.in[I_CCTX];
  float* sl = (float*)lds;
  for (int it = bidx_; it < 4 * 6 * 16; it += gdim_) {
    const int l = it / 96, cb = (it % 96) / 16, ks = it % 16;
    const int col = cb * 512 + tidx_;
    __syncthreads();
    if (tidx_ < 320) { const int v = tidx_ >> 6, k = ks * 64 + (tidx_ & 63); sl[tidx_] = siluf(v == 0 ? cctx[k] : c[(v - 1) * DM + k]); }
    __syncthreads();
    float a[5] = {0.f, 0.f, 0.f, 0.f, 0.f};
    const float* wp = wmod + ((size_t)l * DM + ks * 64) * 3072 + col;
#pragma unroll 1
    for (int k0 = 0; k0 < 64; k0 += 16) {
      float w[16];
#pragma unroll
      for (int j = 0; j < 16; ++j) w[j] = wp[(size_t)(k0 + j) * 3072];
#pragma unroll
      for (int j = 0; j < 16; ++j)
#pragma unroll
        for (int v = 0; v < 5; ++v) a[v] += sl[v * 64 + k0 + j] * w[j];
    }
#pragma unroll
    for (int v = 0; v < 5; ++v) part[((size_t)ks * 20 + l * 5 + v) * 3072 + col] = a[v];
  }
  __syncthreads();
}
__device__ __forceinline__ void phase_mod_reduce(const Params& p, const float* part, float* mod) {
  const int tidx_ = otid(), bidx_ = obid(), gdim_ = ogdim(); (void)tidx_; (void)bidx_; (void)gdim_;
  const float* bmod = p.in[I_BMOD];
  for (int e = bidx_ * NTHREADS + tidx_; e < 20 * 3072; e += gdim_ * NTHREADS) {
    const int lv = e / 3072, col = e % 3072, l = lv / 5;
    float s = bmod[l * 3072 + col];
#pragma unroll
    for (int ks = 0; ks < 16; ++ks) s += part[((size_t)ks * 20 + lv) * 3072 + col];
    mod[e] = s;
  }
}

__device__ __forceinline__ void phase_norm(const Params& p, int layer, const float* mod_l, bf16_t* hN, bf16_t* WinT, bf16_t* WaT, bf16_t* WoutT, unsigned char* lds) {
  const int tidx_ = otid(), bidx_ = obid(), gdim_ = ogdim(); (void)tidx_; (void)bidx_; (void)gdim_;
  const int tid = tidx_, lane = tid & 63, wid = __builtin_amdgcn_readfirstlane(tid >> 6);
  const float* ng = p.in[I_NG] + layer * DM;
  const int rstep = gdim_ * 8;
  int row = bidx_ * 8 + wid;
  f32x4 vn[4];
  if (row < MROWS) { const float* x = (layer == 0) ? (row < NCTXR ? p.in[I_XP] + (size_t)row * DM : p.in[I_XS] + (size_t)(row - NCTXR) * DM) : p.out + (size_t)row * DM;
#pragma unroll
    for (int i = 0; i < 4; ++i) vn[i] = *(const f32x4*)(x + i * 256 + lane * 4); }
  for (; row < MROWS; row += rstep) {
    f32x4 v[4];
#pragma unroll
    for (int i = 0; i < 4; ++i) v[i] = vn[i];
    const int nrow = row + rstep;
    if (nrow < MROWS) { const float* x = (layer == 0) ? (nrow < NCTXR ? p.in[I_XP] + (size_t)nrow * DM : p.in[I_XS] + (size_t)(nrow - NCTXR) * DM) : p.out + (size_t)nrow * DM;
#pragma unroll
      for (int i = 0; i < 4; ++i) vn[i] = *(const f32x4*)(x + i * 256 + lane * 4); }
    const float* mv = mod_l + (size_t)row_vec(row) * 3072;
    float ss = 0.f;
#pragma unroll
    for (int i = 0; i < 4; ++i) ss += (v[i][0] * v[i][0] + v[i][1] * v[i][1]) + (v[i][2] * v[i][2] + v[i][3] * v[i][3]);
#pragma unroll
    for (int o = 1; o < 64; o <<= 1) ss += __shfl_xor(ss, o);
    const float rstd = rsqrtf(ss * (1.f / 1024.f) + 1e-6f);
#pragma unroll
    for (int i = 0; i < 4; ++i) {
      const int c = i * 256 + lane * 4;
      const f32x4 g = *(const f32x4*)(ng + c), sh = *(const f32x4*)(mv + c), scl = *(const f32x4*)(mv + 1024 + c);
      f32x4 y;
#pragma unroll
      for (int j = 0; j < 4; ++j) y[j] = v[i][j] * rstd * g[j] * (1.f + scl[j]) + sh[j];
      u32x2 w; w.x = cvt_pk_bf16(y[0], y[1]); w.y = cvt_pk_bf16(y[2], y[3]);
      *(u32x2*)(hN + (size_t)row * DM + c) = w;
    }
  }
}

__device__ __forceinline__ void phase_wconv(const Params& p, int layer, bf16_t* WinT, bf16_t* WaT, bf16_t* WoutT, unsigned char* lds, int b0, int nb) {
  const int tidx_ = otid(), bidx_ = obid(), gdim_ = ogdim(); (void)tidx_; (void)bidx_; (void)gdim_;
  const int tid = tidx_;
  if (bidx_ < b0 || bidx_ >= b0 + nb) return;
  float* tile = (float*)lds;
  const float* win = p.in[I_WIN] + (size_t)layer * DM * NIN; const float* wout = p.in[I_WOUT] + (size_t)layer * DM * DM;
  const int NT_IN = 16 * 57, NT_ALL = NT_IN + 16 * 16;
  for (int it = bidx_ - b0; it < NT_ALL; it += nb) {
    const bool isin = it < NT_IN; const int t2 = isin ? it : it - NT_IN;
    const int kt = t2 & 15, ntile = t2 >> 4; const int ncols = isin ? NIN : DM; const float* W = isin ? win : wout;
    __syncthreads();
    float wv[8];
#pragma unroll
    for (int i = 0; i < 8; ++i) { const int e = tid + i * 512, kk = e >> 6, nn = e & 63; const int n = ntile * 64 + nn; wv[i] = W[(size_t)(kt * 64 + kk) * ncols + min(n, ncols - 1)]; }
#pragma unroll
    for (int i = 0; i < 8; ++i) { const int e = tid + i * 512, kk = e >> 6, nn = e & 63; const int n = ntile * 64 + nn; tile[kk * 65 + nn] = (n < ncols) ? wv[i] : 0.f; }
    __syncthreads();
    const int nn = tid >> 3, kseg = tid & 7, nl = ntile * 64 + nn;
    if (nl < ncols) {
      u32x4 w; float f[8];
#pragma unroll
      for (int j = 0; j < 8; ++j) f[j] = tile[(kseg * 8 + j) * 65 + nn];
      w.x = cvt_pk_bf16(f[0], f[1]); w.y = cvt_pk_bf16(f[2], f[3]); w.z = cvt_pk_bf16(f[4], f[5]); w.w = cvt_pk_bf16(f[6], f[7]);
      bf16_t* dst;
      if (isin && nl >= NPW) dst = WaT + (size_t)(nl - NPW) * DM;
      else {
        const int gl = nl >> 8, c = nl & 255;
        int gp = gl;
        if (isin) { const int l2p[14] = {0, 4, 5, 6, 1, 7, 8, 9, 2, 10, 11, 12, 3, 13}; gp = l2p[gl]; }
        const int wc = c >> 6, bj = (c >> 5) & 1, t = c & 31, fq = t >> 3, n = (t >> 2) & 1, j = t & 3;
        const int pr = bj * 128 + wc * 32 + n * 16 + fq * 4 + j;
        dst = (isin ? WinT : WoutT) + (size_t)(gp * 256 + pr) * DM;
      }
      *(u32x4*)(dst + kt * 64 + kseg * 8) = w;
    }
  }
  __syncthreads();
}


__device__ __forceinline__ void phase_cachecvt(const Params& p, bf16_t* CKb, bf16_t* CVb) {
  const int tidx_ = otid(), bidx_ = obid(), gdim_ = ogdim(); (void)tidx_; (void)bidx_; (void)gdim_;
  for (int e = bidx_ * NTHREADS + tidx_; e < 2 * 262144; e += gdim_ * NTHREADS) {
    const bool isv = e >= 262144; const int o = (isv ? e - 262144 : e) * 8;
    *(u32x4*)((isv ? CVb : CKb) + o) = __builtin_bit_cast(u32x4, ld_f32x8_as_bf16(p.in[isv ? I_CV : I_CK] + o));
  }
}

__device__ __forceinline__ void phase_afb(const bf16_t* hN, const bf16_t* WaT, float* aFB) {
  const int tidx_ = otid(), bidx_ = obid(), gdim_ = ogdim(); (void)tidx_; (void)bidx_; (void)gdim_;
  const int lane = tidx_ & 63, wid = __builtin_amdgcn_readfirstlane(tidx_ >> 6), rr = lane & 31, hh = lane >> 5;
  const int nheavy = (gdim_ == 256) ? 64 : 0;
  if (bidx_ < nheavy) return;
  for (int it = (bidx_ - nheavy) * 8 + wid; it < MROWS / 32; it += (gdim_ - nheavy) * 8) {
    const bf16_t* a = hN + (size_t)(it * 32 + rr) * DM + hh * 8; const bf16_t* b = WaT + (size_t)rr * DM + hh * 8;
    f32x16 acc = zero16();
#pragma unroll 8
    for (int kk = 0; kk < 64; ++kk) acc = mfma32(ld_frag16(a + kk * 16), ld_frag16(b + kk * 16), acc);
#pragma unroll
    for (int i = 0; i < 16; ++i) { const int r = (i & 3) + 8 * (i >> 2) + 4 * hh; aFB[(size_t)(it * 32 + r) * 32 + rr] = acc[i]; }
  }
}

__device__ __forceinline__ void attn_ctx(bf16_t* P, bf16_t* Y, unsigned char* lds) {
  const int tidx_ = otid(), bidx_ = obid(), gdim_ = ogdim(); (void)tidx_; (void)bidx_; (void)gdim_;
  const int tid = tidx_, lane = tid & 63, wid = __builtin_amdgcn_readfirstlane(tid >> 6), rr = lane & 31, hh = lane >> 5;
  bf16_t* Ks = (bf16_t*)lds; bf16_t* Vt = (bf16_t*)(lds + 36864);
  for (int it = (bidx_ + 128) % gdim_; it < 128; it += gdim_) {
    const int b = it >> 2, h = it & 3; const size_t rb = (size_t)b * 256;
    __syncthreads();
#pragma unroll
    for (int i = 0; i < 4; ++i) { const int c = tid + 512 * i, key = c >> 3, part = c & 7; *(u32x4*)(Ks + key * 72 + part * 8) = *(const u32x4*)(P + (rb + key) * NPW + PKA + h * 64 + part * 8); }
    { const int kq = tid >> 3, part = tid & 7; u32x4 v[4];
#pragma unroll
      for (int i = 0; i < 4; ++i) v[i] = *(const u32x4*)(P + (rb + 4 * kq + i) * NPW + PVA + h * 64 + part * 8);
#pragma unroll
      for (int e = 0; e < 8; ++e) { const int wi = e >> 1; const bool hi = e & 1; unsigned s[4];
#pragma unroll
        for (int i = 0; i < 4; ++i) s[i] = hi ? (v[i][wi] >> 16) : (v[i][wi] & 0xffffu);
        u32x2 w; w.x = s[0] | (s[1] << 16); w.y = s[2] | (s[3] << 16);
        *(u32x2*)(Vt + (part * 8 + e) * 264 + 4 * ((kq & ~3) | ((kq & 1) << 1) | ((kq & 2) >> 1))) = w; } }
    __syncthreads();
    const size_t qrow = rb + wid * 32 + rr;
    bf16x8 qf[4];
#pragma unroll
    for (int ks = 0; ks < 4; ++ks) qf[ks] = ld_frag16(P + qrow * NPW + PQ + h * 64 + ks * 16 + hh * 8);
    float m = -1e30f, l = 0.f;
    f32x16 o[2]; o[0] = zero16(); o[1] = zero16();
#pragma unroll 1
    for (int half = 0; half < 2; ++half) {
      f32x16 acc[4];
#pragma unroll
      for (int j = 0; j < 4; ++j) { acc[j] = zero16(); const int kt = half * 4 + j;
#pragma unroll
        for (int ks = 0; ks < 4; ++ks) acc[j] = mfma32(ld_frag16(Ks + (kt * 32 + rr) * 72 + ks * 16 + hh * 8), qf[ks], acc[j]); }
      float mx = m;
#pragma unroll
      for (int j = 0; j < 4; ++j)
#pragma unroll
        for (int i = 0; i < 16; ++i) mx = fmaxf(mx, acc[j][i]);
      mx = fmaxf(mx, __shfl_xor(mx, 32));
      const float sc = __expf(m - mx); m = mx; l *= sc;
#pragma unroll
      for (int i = 0; i < 16; ++i) { o[0][i] *= sc; o[1][i] *= sc; }
#pragma unroll
      for (int j = 0; j < 4; ++j)
#pragma unroll
        for (int i = 0; i < 16; ++i) { const float e = __expf(acc[j][i] - mx); acc[j][i] = e; l += e; }
#pragma unroll
      for (int j = 0; j < 4; ++j)
#pragma unroll
        for (int s = 0; s < 2; ++s) { const bf16x8 pb = pack8(acc[j], s); const int kt = half * 4 + j;
#pragma unroll
          for (int dt = 0; dt < 2; ++dt) { const bf16_t* vp = Vt + (dt * 32 + rr) * 264 + kt * 32 + 16 * s + 8 * hh; o[dt] = mfma32(ld_frag16(vp), pb, o[dt]); } }
    }
    l += __shfl_xor(l, 32);
    const float inv = 1.f / l;
#pragma unroll
    for (int dt = 0; dt < 2; ++dt)
#pragma unroll
      for (int g4 = 0; g4 < 4; ++g4) { const int d = dt * 32 + 8 * g4 + 4 * hh;
        const u32x2 gw = *(const u32x2*)(P + qrow * NPW + PGA + h * 64 + d);
        u32x2 w; w.x = cvt_pk_bf16(o[dt][4 * g4] * inv * siluf(bflo(gw.x)), o[dt][4 * g4 + 1] * inv * siluf(bfhi(gw.x))); w.y = cvt_pk_bf16(o[dt][4 * g4 + 2] * inv * siluf(bflo(gw.y)), o[dt][4 * g4 + 3] * inv * siluf(bfhi(gw.y)));
        if (Y) *(u32x2*)(Y + qrow * NPW + PQ + h * 64 + d) = w; }
  }
  __syncthreads();
}

template <int MODE>
__device__ __forceinline__ void ad_tile(const bf16_t* Kt, const bf16_t* Vt_, const bf16x8 (&qf)[4], const float* brow, int cs, int rr, int hh, float& mx, float& l, f32x16 (&o)[2]) {
  f32x16 acc[2];
#pragma unroll
  for (int sub = 0; sub < 2; ++sub) { acc[sub] = zero16();
#pragma unroll
    for (int ks = 0; ks < 4; ++ks) acc[sub] = mfma32(ld_frag16(Kt + (sub * 32 + rr) * 72 + ks * 16 + hh * 8), qf[ks], acc[sub]); }
  float m2 = mx;
#pragma unroll
  for (int sub = 0; sub < 2; ++sub)
#pragma unroll
    for (int i = 0; i < 16; ++i) {
      const bool act = (MODE == 0) || (MODE == 1 ? (sub == 0 || i < 4) : (sub == 1 || i >= 12));
      if (act) {
        if (MODE != 0) { const int kc = sub * 32 + (i & 3) + 8 * (i >> 2) + 4 * hh; const bool ok = (kc >= cs) && (kc < cs + 16); acc[sub][i] = ok ? acc[sub][i] + brow[kc] : -1e30f; }
        m2 = fmaxf(m2, acc[sub][i]);
      }
    }
  m2 = fmaxf(m2, __shfl_xor(m2, 32));
  if (__any(m2 > mx + 8.f)) {
    const float sc = __expf(mx - m2); mx = m2; l *= sc;
#pragma unroll
    for (int i = 0; i < 16; ++i) { o[0][i] *= sc; o[1][i] *= sc; }
  }
#pragma unroll
  for (int sub = 0; sub < 2; ++sub)
#pragma unroll
    for (int i = 0; i < 16; ++i) {
      const bool act = (MODE == 0) || (MODE == 1 ? (sub == 0 || i < 4) : (sub == 1 || i >= 12));
      if (act) { const float e = __expf(acc[sub][i] - mx); acc[sub][i] = e; l += e; } else acc[sub][i] = 0.f;
    }
#pragma unroll
  for (int sub = 0; sub < 2; ++sub)
#pragma unroll
    for (int s = 0; s < 2; ++s) {
      const bool need = (MODE == 0) || (MODE == 1 ? (sub == 0 || s == 0) : (sub == 1 || s == 1));
      if (need) { const bf16x8 pb = pack8(acc[sub], s);
#pragma unroll
        for (int dt = 0; dt < 2; ++dt) { const bf16_t* vp = Vt_ + (dt * 32 + rr) * 72 + sub * 32 + 16 * s + 8 * hh; o[dt] = mfma32(ld_frag16(vp), pb, o[dt]); } }
    }
}

__device__ __forceinline__ void attn_den(const Params& p, int layer, bf16_t* P, bf16_t* Y, unsigned char* lds) {
  const int tidx_ = otid(), bidx_ = obid(), gdim_ = ogdim(); (void)tidx_; (void)bidx_; (void)gdim_;
  const int tid = tidx_, lane = tid & 63, wid = __builtin_amdgcn_readfirstlane(tid >> 6), rr = lane & 31, hh = lane >> 5;
  bf16_t* Kb = (bf16_t*)lds;
  bf16_t* Vb = (bf16_t*)(lds + 18432);
  float* rpbs = (float*)(lds + 36864);
  const bf16_t* CKb = (const bf16_t*)(p.ws + WS_CKB); const bf16_t* CVb = (const bf16_t*)(p.ws + WS_CVB); const float* rpb = p.in[I_RPB];
  const int skey = tid >> 3, spart = tid & 7;
  const int skeyp = (skey & ~12) | ((skey & 4) << 1) | ((skey & 8) >> 1);
  for (int it = bidx_; it < 256; it += gdim_) {
    const int b = it >> 6, h = (it >> 4) & 3, r0 = (it & 15) * 4;
    const size_t rb = (size_t)NCTXR + (size_t)b * 4096;
    const size_t cbase = (((size_t)b * 4 + layer) * 4 + h) * 512 * 64;
    const int r = r0 + (wid >> 1), qhalf = wid & 1;
    const int rs = min(max(r - 4, 0), 56);
    const int R0 = min(max(r0 - 4, 0), 56), nlat = min(max(r0 - 1, 0), 56) + 8 - R0, T = nlat + 8;
    __syncthreads();
    if (tid < 480) { const int dr = tid >> 5, dc = tid & 31; rpbs[tid] = dc < 31 ? rpb[(((size_t)layer * 4 + h) * 15 + dr) * 31 + dc] : 0.f; }
    const size_t qtok = rb + (size_t)r * 64 + qhalf * 32 + rr;
    bf16x8 qf[4];
#pragma unroll
    for (int ks = 0; ks < 4; ++ks) qf[ks] = ld_frag16(P + qtok * NPW + PQ + h * 64 + ks * 16 + hh * 8);
    const int qc = qhalf * 32 + rr; const int cs = min(max(qc - 8, 0), 48);
    u32x4 kA, vA, kB, vB;
#define AD_LOAD(j, kreg, vreg) do { if ((j) < nlat) { const size_t t0 = rb + (size_t)(R0 + (j)) * 64; \
        kreg = *(const u32x4*)(P + (t0 + skey) * NPW + PKA + h * 64 + spart * 8); \
        vreg = *(const u32x4*)(P + (t0 + skey) * NPW + PVA + h * 64 + spart * 8); \
      } else { const int c_ = (j) - nlat; \
        kreg = *(const u32x4*)(CKb + cbase + (size_t)(c_ * 64 + skey) * 64 + spart * 8); \
        vreg = *(const u32x4*)(CVb + cbase + (size_t)(c_ * 64 + skey) * 64 + spart * 8); } } while (0)
#define AD_WRITE(buf, kreg, vreg) do { *(u32x4*)(Kb + (buf) * 4608 + skey * 72 + spart * 8) = kreg; \
      _Pragma("unroll") for (int e_ = 0; e_ < 8; ++e_) { const unsigned w_ = vreg[e_ >> 1]; \
        Vb[(buf) * 4608 + (spart * 8 + e_) * 72 + skeyp] = (bf16_t)((e_ & 1) ? (w_ >> 16) : (w_ & 0xffffu)); } } while (0)
#define AD_COMPUTE(j) do { const int buf = (j) & 1; const bool lat = (j) < nlat; const int R = R0 + (j); \
      const bool use = !lat || (R >= rs && R < rs + 8); \
      if (use) { const bf16_t* Kt = Kb + buf * 4608; const bf16_t* Vt_ = Vb + buf * 4608; const float* brow = rpbs + (R - r + 7) * 32 + 15 - qc; \
        if (!lat) ad_tile<0>(Kt, Vt_, qf, brow, cs, rr, hh, mx, l, o); \
        else if (qhalf == 0) ad_tile<1>(Kt, Vt_, qf, brow, cs, rr, hh, mx, l, o); \
        else ad_tile<2>(Kt, Vt_, qf, brow, cs, rr, hh, mx, l, o); } } while (0)
    AD_LOAD(0, kB, vB);
    AD_WRITE(0, kB, vB);
    AD_LOAD(1, kA, vA);
    __syncthreads();
    float mx = -1e30f, l = 0.f;
    f32x16 o[2]; o[0] = zero16(); o[1] = zero16();
#pragma unroll 1
    for (int j = 0; j < T; j += 2) {
      if (j + 2 < T) AD_LOAD(j + 2, kB, vB);
      AD_COMPUTE(j);
      if (j + 1 < T) AD_WRITE(1, kA, vA);
      __syncthreads();
      if (j + 1 < T) {
        if (j + 3 < T) AD_LOAD(j + 3, kA, vA);
        AD_COMPUTE(j + 1);
        if (j + 2 < T) AD_WRITE(0, kB, vB);
        __syncthreads();
      }
    }
#undef AD_LOAD
#undef AD_WRITE
#undef AD_COMPUTE
    l += __shfl_xor(l, 32);
    const float inv = 1.f / l;
#pragma unroll
    for (int dt = 0; dt < 2; ++dt)
#pragma unroll
      for (int g4 = 0; g4 < 4; ++g4) { const int d = dt * 32 + 8 * g4 + 4 * hh;
        const u32x2 gw = *(const u32x2*)(P + qtok * NPW + PGA + h * 64 + d);
        u32x2 w; w.x = cvt_pk_bf16(o[dt][4 * g4] * inv * siluf(bflo(gw.x)), o[dt][4 * g4 + 1] * inv * siluf(bfhi(gw.x))); w.y = cvt_pk_bf16(o[dt][4 * g4 + 2] * inv * siluf(bflo(gw.y)), o[dt][4 * g4 + 3] * inv * siluf(bfhi(gw.y)));
        if (Y) *(u32x2*)(Y + qtok * NPW + PQ + h * 64 + d) = w; }
  }
  __syncthreads();
}

__device__ __forceinline__ void conv_mix(const Params& p, int layer, bf16_t* P, bf16_t* Y) {
  const int tidx_ = otid(), bidx_ = obid(), gdim_ = ogdim(); (void)tidx_; (void)bidx_; (void)gdim_;
  const float* cw = p.in[I_CONV] + layer * 768;
  const long long total = (long long)MROWS * 32, stride = (long long)gdim_ * NTHREADS;
  for (long long e0 = (long long)bidx_ * NTHREADS + tidx_; e0 < total; e0 += 2 * stride) {
    u32x4 cv[2][3], hv[2][3], bv[2], gv[2]; float ml[2], mr[2]; int rowv[2], cc[2]; bool live[2];
#pragma unroll
    for (int q = 0; q < 2; ++q) {
      const long long e = e0 + q * stride; live[q] = e < total; const long long ee = live[q] ? e : e0;
      const int row = (int)(ee >> 5), c = (int)(ee & 31) * 8; rowv[q] = row; cc[q] = c;
      int s, S; if (row < NCTXR) { s = row & 255; S = 256; } else { s = (row - NCTXR) & 4095; S = 4096; }
      const bool hl = s > 0, hr = s < S - 1; ml[q] = hl ? 1.f : 0.f; mr[q] = hr ? 1.f : 0.f;
      const bf16_t* pr = P + (size_t)row * NPW; const bf16_t* pl = hl ? pr - NPW : pr; const bf16_t* pn = hr ? pr + NPW : pr;
      cv[q][0] = *(const u32x4*)(pl + PCB + c); hv[q][0] = *(const u32x4*)(pl + PHB + c);
      cv[q][1] = *(const u32x4*)(pr + PCB + c); hv[q][1] = *(const u32x4*)(pr + PHB + c);
      cv[q][2] = *(const u32x4*)(pn + PCB + c); hv[q][2] = *(const u32x4*)(pn + PHB + c);
      bv[q] = *(const u32x4*)(pr + PBB + c); gv[q] = *(const u32x4*)(pr + PGB + c);
    }
#pragma unroll
    for (int q = 0; q < 2; ++q) {
      const int c = cc[q];
      float y[8];
#pragma unroll
      for (int j = 0; j < 8; ++j) {
        const int wj = j >> 1; const bool hi = j & 1;
        const float u0 = (hi ? bfhi(cv[q][0][wj]) * bfhi(hv[q][0][wj]) : bflo(cv[q][0][wj]) * bflo(hv[q][0][wj])) * ml[q];
        const float u1 = hi ? bfhi(cv[q][1][wj]) * bfhi(hv[q][1][wj]) : bflo(cv[q][1][wj]) * bflo(hv[q][1][wj]);
        const float u2 = (hi ? bfhi(cv[q][2][wj]) * bfhi(hv[q][2][wj]) : bflo(cv[q][2][wj]) * bflo(hv[q][2][wj])) * mr[q];
        const float conv = u0 * cw[c + j] + u1 * cw[256 + c + j] + u2 * cw[512 + c + j];
        const float bb = hi ? bfhi(bv[q][wj]) : bflo(bv[q][wj]); const float gg = siluf(hi ? bfhi(gv[q][wj]) : bflo(gv[q][wj]));
        y[j] = bb * conv * gg;
      }
      u32x4 w; w.x = cvt_pk_bf16(y[0], y[1]); w.y = cvt_pk_bf16(y[2], y[3]); w.z = cvt_pk_bf16(y[4], y[5]); w.w = cvt_pk_bf16(y[6], y[7]);
      if (Y && live[q]) *(u32x4*)(Y + (size_t)rowv[q] * NPW + PBB + c) = w;
    }
  }
}

__device__ __forceinline__ void fourier_tables(unsigned char* lds) {
  const int tidx_ = otid(), bidx_ = obid(), gdim_ = ogdim(); (void)tidx_; (void)bidx_; (void)gdim_;
  bf16_t* T = (bf16_t*)lds;
  for (int e = tidx_; e < 4096; e += NTHREADS) { const int a = e >> 6, b = e & 63; const float x = (float)((a * b) & 63) * (1.f / 64.f);
    T[a * 72 + b] = f2bf(__builtin_amdgcn_cosf(x)); T[4608 + a * 72 + b] = f2bf(__builtin_amdgcn_sinf(x));
    const bool in4 = (a < 32) && (b < 32) && ((a >> 2) == (b >> 2)); const float y = (float)(((a & 3) * (b & 3)) & 3) * 0.25f;
    T[9216 + a * 72 + b] = in4 ? f2bf(__builtin_amdgcn_cosf(y)) : (bf16_t)0; T[13824 + a * 72 + b] = in4 ? f2bf(__builtin_amdgcn_sinf(y)) : (bf16_t)0; }
}
__device__ __forceinline__ bf16x8 neg_bf16x8(bf16x8 v) { u32x4 w = __builtin_bit_cast(u32x4, v); w.x ^= 0x80008000u; w.y ^= 0x80008000u; w.z ^= 0x80008000u; w.w ^= 0x80008000u; return as_bf16x8(w); }

template <bool DEN>
__device__ __forceinline__ void fourier1_item(int t2, const bf16_t* P, bf16_t* Zr, bf16_t* Zi, unsigned char* lds) {
  const int tidx_ = otid(), bidx_ = obid(), gdim_ = ogdim(); (void)tidx_; (void)bidx_; (void)gdim_;
  const int tid = tidx_, lane = tid & 63, wid = __builtin_amdgcn_readfirstlane(tid >> 6), rr = lane & 31, hh = lane >> 5;
  const bf16_t* T = (const bf16_t*)lds;
  bf16_t* Xr = (bf16_t*)(lds + 36864); bf16_t* Xi = (bf16_t*)(lds + 36864 + 32768);
  constexpr int NS1 = DEN ? 64 : 4, NKAT = DEN ? 2 : 1, NSS = DEN ? 4 : 1, NST = DEN ? 2 : 1;
  const int jh = t2 & 1, sblk = (t2 >> 1) & 7, bg = t2 >> 4, g = bg & 3, b = bg >> 2;
  const size_t rb = DEN ? (size_t)NCTXR + (size_t)b * 4096 : (size_t)b * 256;
  const int s2 = sblk * 8 + wid;
  const bf16_t* Tc = DEN ? T : T + 9216; const bf16_t* Ts = DEN ? T + 4608 : T + 13824;
  f32x16 uc[NST], us[NST];
  {
    bf16x8 bc[4], bs[4];
#pragma unroll
    for (int ks = 0; ks < 4; ++ks) { bc[ks] = ld_frag16(T + (jh * 32 + rr) * 72 + ks * 16 + hh * 8); bs[ks] = ld_frag16(T + 4608 + (jh * 32 + rr) * 72 + ks * 16 + hh * 8); }
#pragma unroll
    for (int st = 0; st < NST; ++st) { uc[st] = zero16(); us[st] = zero16();
      const int s1 = st * 32 + rr; const bool valid = s1 < NS1;
      const bf16_t* up = P + (rb + (size_t)(valid ? s1 : 0) * 64 + s2) * NPW + PUC + g * 64 + hh * 8;
#pragma unroll
      for (int ks = 0; ks < 4; ++ks) { u32x4 raw = *(const u32x4*)(up + ks * 16); if (!valid) raw = (u32x4){0u, 0u, 0u, 0u}; const bf16x8 a = as_bf16x8(raw); uc[st] = mfma32(a, bc[ks], uc[st]); us[st] = mfma32(a, bs[ks], us[st]); } }
  }
  bf16x8 puc[NSS], pus[NSS], pun[NSS];
#pragma unroll
  for (int s = 0; s < NSS; ++s) { puc[s] = pack8(uc[s >> 1], s & 1); pus[s] = pack8(us[s >> 1], s & 1); pun[s] = neg_bf16x8(pus[s]); }
  constexpr float nrm = DEN ? (1.f / 512.f) : (1.f / 128.f), invS = DEN ? (1.f / 4096.f) : (1.f / 256.f);
  __syncthreads();
#pragma unroll
  for (int kat = 0; kat < NKAT; ++kat) {
    f32x16 yr = zero16(), ys = zero16();
#pragma unroll
    for (int s = 0; s < NSS; ++s) {
      const bf16_t* tc = Tc + (kat * 32 + rr) * 72 + 16 * s + 4 * hh; const bf16_t* ts = Ts + (kat * 32 + rr) * 72 + 16 * s + 4 * hh;
      const bf16x8 ac = ld_frag8x2(tc, tc + 8), as = ld_frag8x2(ts, ts + 8);
      yr = mfma32(ac, puc[s], yr); yr = mfma32(as, pun[s], yr);
      ys = mfma32(ac, pus[s], ys); ys = mfma32(as, puc[s], ys);
    }
#pragma unroll
    for (int i = 0; i < 16; ++i) { const int ka = kat * 32 + (i & 3) + 8 * (i >> 2) + 4 * hh;
      const float th = (float)((ka * s2) & (DEN ? 4095 : 255)) * invS; const float c = __builtin_amdgcn_cosf(th), s = __builtin_amdgcn_sinf(th);
      const float zr = (yr[i] * c - ys[i] * s) * nrm, zi = (-ys[i] * c - yr[i] * s) * nrm;
      Xr[(ka * 32 + rr) * 8 + wid] = f2bf(zr); Xi[(ka * 32 + rr) * 8 + wid] = f2bf(zi); }
  }
  __syncthreads();
  { constexpr int nka = DEN ? 64 : 4; const size_t zb = DEN ? (size_t)512 + (size_t)bg * 64 : (size_t)bg * 4;
    for (int c = tid; c < nka * 32; c += NTHREADS) { const int ka = c >> 5, jl = c & 31;
      const size_t zo = ((zb + ka) * 64 + jh * 32 + jl) * 64 + sblk * 8;
      *(u32x4*)(Zr + zo) = *(const u32x4*)(Xr + c * 8); *(u32x4*)(Zi + zo) = *(const u32x4*)(Xi + c * 8); } }
}
__device__ __forceinline__ void fourier1_ctx(const bf16_t* P, bf16_t* Zr, bf16_t* Zi, unsigned char* lds) {
  const int tidx_ = otid(), bidx_ = obid(), gdim_ = ogdim(); (void)tidx_; (void)bidx_; (void)gdim_;
  const int tid = tidx_, lane = tid & 63, wid = __builtin_amdgcn_readfirstlane(tid >> 6), rr = lane & 31, hh = lane >> 5;
  const bf16_t* T = (const bf16_t*)lds;
  for (int it = bidx_ * 8 + wid; it < 1024; it += gdim_ * 8) {
    const int sblk = it & 7, bg = it >> 3, g = bg & 3, b = bg >> 2;
    const size_t rb = (size_t)b * 256;
    const bf16_t* up = P + (rb + (size_t)(rr & 3) * 64 + sblk * 8 + (rr >> 2)) * NPW + PUC + g * 64 + hh * 8;
    bf16x8 a[4];
#pragma unroll
    for (int ks = 0; ks < 4; ++ks) a[ks] = ld_frag16(up + ks * 16);
#pragma unroll 1
    for (int jt = 0; jt < 2; ++jt) {
      f32x16 uc = zero16(), us = zero16();
#pragma unroll
      for (int ks = 0; ks < 4; ++ks) { uc = mfma32(a[ks], ld_frag16(T + (jt * 32 + rr) * 72 + ks * 16 + hh * 8), uc); us = mfma32(a[ks], ld_frag16(T + 4608 + (jt * 32 + rr) * 72 + ks * 16 + hh * 8), us); }
      f32x16 yr = zero16(), ys = zero16();
#pragma unroll
      for (int s = 0; s < 2; ++s) {
        const bf16x8 puc = pack8(uc, s), pus = pack8(us, s), pun = neg_bf16x8(pus);
        const bf16_t* tc = T + 9216 + rr * 72 + 16 * s + 4 * hh; const bf16_t* ts = T + 13824 + rr * 72 + 16 * s + 4 * hh;
        const bf16x8 ac = ld_frag8x2(tc, tc + 8), as = ld_frag8x2(ts, ts + 8);
        yr = mfma32(ac, puc, yr); yr = mfma32(as, pun, yr);
        ys = mfma32(ac, pus, ys); ys = mfma32(as, puc, ys);
      }
      float zr[16], zi[16];
#pragma unroll
      for (int i = 0; i < 16; ++i) { const int ka = i & 3, s2 = sblk * 8 + 2 * (i >> 2) + hh;
        const float th = (float)((ka * s2) & 255) * (1.f / 256.f); const float c = __builtin_amdgcn_cosf(th), s = __builtin_amdgcn_sinf(th);
        zr[i] = (yr[i] * c - ys[i] * s) * (1.f / 128.f); zi[i] = (-ys[i] * c - yr[i] * s) * (1.f / 128.f); }
#pragma unroll
      for (int ka = 0; ka < 4; ++ka) {
        u32x4 wr_, wi_;
#pragma unroll
        for (int m = 0; m < 4; ++m) {
          const float mr = zr[ka + 4 * m], mi = zi[ka + 4 * m];
          const float orr = __shfl_xor(mr, 32), oi = __shfl_xor(mi, 32);
          wr_[m] = hh ? cvt_pk_bf16(orr, mr) : cvt_pk_bf16(mr, orr);
          wi_[m] = hh ? cvt_pk_bf16(oi, mi) : cvt_pk_bf16(mi, oi);
        }
        const size_t zo = (((size_t)bg * 4 + ka) * 64 + jt * 32 + rr) * 64 + sblk * 8;
        if (hh == 0) *(u32x4*)(Zr + zo) = wr_; else *(u32x4*)(Zi + zo) = wi_;
      }
    }
  }
}
__device__ __forceinline__ void fourier1(const bf16_t* P, bf16_t* Zr, bf16_t* Zi, unsigned char* lds) {
  const int tidx_ = otid(), bidx_ = obid(), gdim_ = ogdim(); (void)tidx_; (void)bidx_; (void)gdim_;
  __syncthreads();
  fourier_tables(lds);
  __syncthreads();
#pragma unroll 1
  for (int it = bidx_; it < 256; it += gdim_) fourier1_item<true>(it, P, Zr, Zi, lds);
  fourier1_ctx(P, Zr, Zi, lds);
  __syncthreads();
}

__device__ __forceinline__ void fourier2(bf16_t* P, const bf16_t* Zr, const bf16_t* Zi, unsigned char* lds) {
  const int tidx_ = otid(), bidx_ = obid(), gdim_ = ogdim(); (void)tidx_; (void)bidx_; (void)gdim_;
  const int tid = tidx_, lane = tid & 63, wid = __builtin_amdgcn_readfirstlane(tid >> 6), rr = lane & 31, hh = lane >> 5;
  const bf16_t* T = (const bf16_t*)lds;
  __syncthreads();
  fourier_tables(lds);
  __syncthreads();
  for (int it = bidx_ * 8 + wid; it < 1024 + 512; it += gdim_ * 8) {
    const bool den = it < 1024; const int t2 = den ? it : it - 1024;
    int ka, bg; if (den) { ka = t2 & 63; bg = t2 >> 6; } else { ka = t2 & 3; bg = t2 >> 2; }
    const int g = bg & 3, b = bg >> 2; const int NS1 = den ? 64 : 4;
    const size_t rb = den ? (size_t)NCTXR + (size_t)b * 4096 : (size_t)b * 256;
    const size_t zb = ((den ? (size_t)512 + (size_t)bg * 64 : (size_t)bg * 4) + ka) * 4096;
    bf16x8 zr[2][4], zi[2][4]; u32x2 gwv[2][2][4];
#pragma unroll
    for (int jt = 0; jt < 2; ++jt)
#pragma unroll
      for (int s = 0; s < 4; ++s) { const size_t o = zb + (size_t)(jt * 32 + rr) * 64 + 16 * s + 8 * hh; zr[jt][s] = ld_frag16(Zr + o); zi[jt][s] = ld_frag16(Zi + o); }
#pragma unroll
    for (int jt = 0; jt < 2; ++jt)
#pragma unroll
      for (int kbt = 0; kbt < 2; ++kbt) { const size_t tok = rb + ka + (size_t)NS1 * (kbt * 32 + rr);
#pragma unroll
        for (int g4 = 0; g4 < 4; ++g4) gwv[jt][kbt][g4] = *(const u32x2*)(P + tok * NPW + PGC + g * 64 + jt * 32 + 8 * g4 + 4 * hh); }
#pragma unroll
    for (int jt = 0; jt < 2; ++jt) {
#pragma unroll
      for (int kbt = 0; kbt < 2; ++kbt) {
        f32x16 x = zero16();
#pragma unroll
        for (int s = 0; s < 4; ++s) { x = mfma32(zr[jt][s], ld_frag16(T + (kbt * 32 + rr) * 72 + 16 * s + 8 * hh), x); x = mfma32(zi[jt][s], ld_frag16(T + 4608 + (kbt * 32 + rr) * 72 + 16 * s + 8 * hh), x); }
        const size_t tok = rb + ka + (size_t)NS1 * (kbt * 32 + rr);
#pragma unroll
        for (int g4 = 0; g4 < 4; ++g4) { const int ch = g * 64 + jt * 32 + 8 * g4 + 4 * hh;
          const u32x2 gw = gwv[jt][kbt][g4];
          u32x2 w; w.x = cvt_pk_bf16(x[4 * g4] * siluf(bflo(gw.x)), x[4 * g4 + 1] * siluf(bfhi(gw.x))); w.y = cvt_pk_bf16(x[4 * g4 + 2] * siluf(bflo(gw.y)), x[4 * g4 + 3] * siluf(bfhi(gw.y)));
          *(u32x2*)(P + tok * NPW + PUC + ch) = w; }
      }
    }
  }
}

__device__ __forceinline__ int gla_slot(bool den, int b, int h, int dir) { return den ? 1024 + ((b * 4 + h) * 2 + dir) * 64 : ((b * 4 + h) * 2 + dir) * 4; }
__device__ __forceinline__ void gla_decay(const Params& p, int layer, int h, size_t rb, const float* aFB, float* SEGv, int tt, int dkt, int rr, int hh, float (&G)[2][16], float (&tot)[2]) {
  const int dkc = dkt * 32 + rr;
  const int tau = 16 * ((rr >> 2) & 1) + (rr & 3) + 4 * (rr >> 3);
#pragma unroll
  for (int dir = 0; dir < 2; ++dir) {
    const float* up = p.in[dir ? I_UPB : I_UPF] + (size_t)layer * 16 * 256 + h * 64 + dkc + (size_t)(8 * hh) * 256;
    u32x4 ub; ub.x = cvt_pk_bf16(up[0], up[256]); ub.y = cvt_pk_bf16(up[512], up[768]); ub.z = cvt_pk_bf16(up[1024], up[1280]); ub.w = cvt_pk_bf16(up[1536], up[1792]);
    const float bias = p.in[dir ? I_BB : I_BF][layer * 256 + h * 64 + dkc];
    const bf16x8 af = ld_f32x8_as_bf16(aFB + (rb + tt * 32 + tau) * 32 + dir * 16 + 8 * hh);
    const f32x16 z = mfma32(af, as_bf16x8(ub), zero16());
    float run = 0.f;
    if (dir == 0) {
#pragma unroll
      for (int i = 0; i < 16; ++i) { run += logsigf(z[i] + bias) * (1.f / 16.f); G[0][i] = run; }
    } else {
#pragma unroll
      for (int i = 15; i >= 0; --i) { run += logsigf(z[i] + bias) * (1.f / 16.f); G[1][i] = run; }
    }
    SEGv[(dir * 4 + tt * 2 + hh) * 64 + dkc] = run;
  }
  __syncthreads();
#pragma unroll
  for (int dir = 0; dir < 2; ++dir) {
    float run = 0.f, excl = 0.f, incl = 0.f;
#pragma unroll
    for (int s = 0; s < 4; ++s) { const float v = SEGv[(dir * 4 + s) * 64 + dkc]; const bool mine = (s == tt * 2 + hh); excl = mine ? run : excl; incl = mine ? run + v : incl; run += v; }
    tot[dir] = run;
    const float off = dir ? (run - incl) : excl;
#pragma unroll
    for (int i = 0; i < 16; ++i) G[dir][i] += off;
  }
}
__device__ __forceinline__ void gla1(const Params& p, int layer, const bf16_t* P, const float* aFB, bf16_t* ST, float* DEC, unsigned char* lds) {
  const int tidx_ = otid(), bidx_ = obid(), gdim_ = ogdim(); (void)tidx_; (void)bidx_; (void)gdim_;
  const int tid = tidx_, lane = tid & 63, wid = __builtin_amdgcn_readfirstlane(tid >> 6), rr = lane & 31, hh = lane >> 5;
  const int half = wid >> 2, lw = wid & 3, ltid = tid & 255;
  unsigned char* lb = lds + half * 40960;
  bf16_t* KE = (bf16_t*)lb;
  bf16_t* VT = (bf16_t*)(lb + 18432);
  float* SEGv = (float*)(lb + 27648);
  const int tt = lw & 1, dkt = lw >> 1, dkc = dkt * 32 + rr;
  for (int it2 = bidx_; it2 < 768; it2 += gdim_) {
    const int it = it2 * 2 + half;
    bool den; int b, h, n, NC;
    if (it < 1024) { den = true; NC = 64; n = it & 63; h = (it >> 6) & 3; b = it >> 8; }
    else { const int t2 = it - 1024; den = false; NC = 4; n = t2 & 3; h = (t2 >> 2) & 3; b = t2 >> 4; }
    const size_t rb = (den ? (size_t)NCTXR + (size_t)b * 4096 : (size_t)b * 256) + (size_t)n * 64;
    float kv[16];
#pragma unroll
    for (int i = 0; i < 16; ++i) kv[i] = bf2f(P[(rb + tt * 32 + 16 * hh + i) * NPW + PKD + h * 64 + dkc]);
    u32x4 vst[4];
    if (ltid < 128) {
#pragma unroll
      for (int i = 0; i < 4; ++i) vst[i] = *(const u32x4*)(P + (rb + 4 * (ltid >> 3) + i) * NPW + PVD + h * 64 + (ltid & 7) * 8);
    }
    __syncthreads();
    float G[2][16], tot[2];
    gla_decay(p, layer, h, rb, aFB, SEGv, tt, dkt, rr, hh, G, tot);
#pragma unroll
    for (int dir = 0; dir < 2; ++dir) {
      { float e[16];
#pragma unroll
        for (int q = 0; q < 16; ++q) e[q] = kv[q] * __expf(tot[dir] - G[dir][q]);
        u32x4 w0, w1;
        w0.x = cvt_pk_bf16(e[0], e[1]); w0.y = cvt_pk_bf16(e[2], e[3]); w0.z = cvt_pk_bf16(e[4], e[5]); w0.w = cvt_pk_bf16(e[6], e[7]);
        w1.x = cvt_pk_bf16(e[8], e[9]); w1.y = cvt_pk_bf16(e[10], e[11]); w1.z = cvt_pk_bf16(e[12], e[13]); w1.w = cvt_pk_bf16(e[14], e[15]);
        *(u32x4*)(KE + dir * 4608 + dkc * 72 + tt * 32 + 16 * hh) = w0; *(u32x4*)(KE + dir * 4608 + dkc * 72 + tt * 32 + 16 * hh + 8) = w1; }
      if (tt == 0 && hh == 0) { const int slot = gla_slot(den, b, h, dir) + (dir ? NC - 1 - n : n); DEC[(size_t)slot * 64 + dkc] = __expf(tot[dir]); }
    }
    if (ltid < 128) {
      const int tq2 = ltid >> 3, part = ltid & 7;
#pragma unroll
      for (int e = 0; e < 8; ++e) { const int wi = e >> 1; const bool hi = e & 1; unsigned s[4];
#pragma unroll
        for (int i = 0; i < 4; ++i) s[i] = hi ? (vst[i][wi] >> 16) : (vst[i][wi] & 0xffffu);
        u32x2 w; w.x = s[0] | (s[1] << 16); w.y = s[2] | (s[3] << 16);
        *(u32x2*)(VT + (part * 8 + e) * 72 + 4 * tq2) = w; }
    }
    __syncthreads();
    {
      const int dkt2 = lw & 1, dvt = lw >> 1;
#pragma unroll
      for (int dir = 0; dir < 2; ++dir) {
        f32x16 acc = zero16();
#pragma unroll
        for (int ks = 0; ks < 4; ++ks) acc = mfma32(ld_frag16(KE + dir * 4608 + (dkt2 * 32 + rr) * 72 + ks * 16 + hh * 8), ld_frag16(VT + (dvt * 32 + rr) * 72 + ks * 16 + hh * 8), acc);
        const int slot = gla_slot(den, b, h, dir) + (dir ? NC - 1 - n : n);
        bf16_t* st = ST + (size_t)slot * 4096 + (dvt * 32 + rr) * 64 + dkt2 * 32 + 4 * hh;
#pragma unroll
        for (int g4 = 0; g4 < 4; ++g4) { u32x2 w; w.x = cvt_pk_bf16(acc[4 * g4], acc[4 * g4 + 1]); w.y = cvt_pk_bf16(acc[4 * g4 + 2], acc[4 * g4 + 3]); *(u32x2*)(st + 8 * g4) = w; }
      }
    }
  }
  __syncthreads();
}
__device__ __forceinline__ void gla2(const Params& p, int layer, bf16_t* ST, const float* DEC) {
  const int tidx_ = otid(), bidx_ = obid(), gdim_ = ogdim(); (void)tidx_; (void)bidx_; (void)gdim_;
  const float* sg = p.in[I_SG];
  for (int it = bidx_; it < 512; it += gdim_) {
    const int e = (it & 7) * 512 + tidx_, dv = e >> 6, dk = e & 63;
    if (it < 256) {
      const int s2 = it >> 3; const int dir = s2 & 1, h = (s2 >> 1) & 3, b = s2 >> 3;
      const int slot0 = gla_slot(true, b, h, dir);
      float S = sg[(((((size_t)b * 4 + layer) * 2 + dir) * 4 + h) * 64 + dk) * 64 + dv];
#pragma unroll 1
      for (int n0 = 0; n0 < 64; n0 += 32) {
        float u[32], d[32];
#pragma unroll
        for (int j = 0; j < 32; ++j) { u[j] = bf2f(ST[(size_t)(slot0 + n0 + j) * 4096 + e]); d[j] = DEC[(size_t)(slot0 + n0 + j) * 64 + dk]; }
#pragma unroll
        for (int j = 0; j < 32; ++j) { ST[(size_t)(slot0 + n0 + j) * 4096 + e] = f2bf(S); S = d[j] * S + u[j]; }
      }
    } else {
      const int oct = (it - 256) >> 3;
      float u[8][4], d[8][4];
#pragma unroll
      for (int q = 0; q < 8; ++q) { const int slot0 = (oct * 8 + q) * 4;
#pragma unroll
        for (int j = 0; j < 4; ++j) { u[q][j] = bf2f(ST[(size_t)(slot0 + j) * 4096 + e]); d[q][j] = DEC[(size_t)(slot0 + j) * 64 + dk]; } }
#pragma unroll
      for (int q = 0; q < 8; ++q) { const int s2 = oct * 8 + q; const int dir = s2 & 1, h = (s2 >> 1) & 3, b = s2 >> 3; const int slot0 = s2 * 4;
        float S = 0.f;
#pragma unroll
        for (int j = 0; j < 4; ++j) { ST[(size_t)(slot0 + j) * 4096 + e] = f2bf(S); S = d[q][j] * S + u[q][j]; }
        p.out[OFF_ST + (((((size_t)b * 4 + layer) * 2 + dir) * 4 + h) * 64 + dk) * 64 + dv] = S; }
    }
  }
}
__device__ __forceinline__ void gla3(const Params& p, int layer, bf16_t* P, bf16_t* Y, const float* aFB, const bf16_t* ST, unsigned char* lds) {
  const int tidx_ = otid(), bidx_ = obid(), gdim_ = ogdim(); (void)tidx_; (void)bidx_; (void)gdim_;
  const int tid = tidx_, lane = tid & 63, wid = __builtin_amdgcn_readfirstlane(tid >> 6), rr = lane & 31, hh = lane >> 5;
  const int half = wid >> 2, lw = wid & 3, ltid = tid & 255;
  unsigned char* lb = lds + half * 65536;
  bf16_t* QD = (bf16_t*)lb;
  bf16_t* KI = (bf16_t*)(lb + 18432);
  bf16_t* VT = (bf16_t*)(lb + 36864);
  float* SS = (float*)(lb + 46080);
  float* SEG = (float*)(lb + 46592);
  const float* gn = p.in[I_GN] + layer * 64;
  for (int it2 = bidx_; it2 < 768; it2 += gdim_) {
    const int it = it2 * 2 + half;
    bool den; int b, h, n, NC;
    if (it < 1024) { den = true; NC = 64; n = it & 63; h = (it >> 6) & 3; b = it >> 8; }
    else { const int t2 = it - 1024; den = false; NC = 4; n = t2 & 3; h = (t2 >> 2) & 3; b = t2 >> 4; }
    const size_t rb = (den ? (size_t)NCTXR + (size_t)b * 4096 : (size_t)b * 256) + (size_t)n * 64;
    const int tt = lw & 1, dvt = lw >> 1;
    bf16x8 stf[2][4]; u32x2 gwv[4];
#pragma unroll
    for (int dir = 0; dir < 2; ++dir) { const int slot = gla_slot(den, b, h, dir) + (dir ? NC - 1 - n : n); const bf16_t* st = ST + (size_t)slot * 4096 + (dvt * 32 + rr) * 64 + hh * 8;
#pragma unroll
      for (int ks = 0; ks < 4; ++ks) stf[dir][ks] = ld_frag16(st + ks * 16); }
    { const size_t tok2 = rb + tt * 32 + rr;
#pragma unroll
      for (int g4 = 0; g4 < 4; ++g4) gwv[g4] = *(const u32x2*)(P + tok2 * NPW + PGD + h * 64 + dvt * 32 + 8 * g4 + 4 * hh); }
    const int dkt = dvt, dkc = dkt * 32 + rr;
    float qv[16], kv[16];
#pragma unroll
    for (int i = 0; i < 16; ++i) { const size_t tok = rb + tt * 32 + 16 * hh + i; qv[i] = bf2f(P[tok * NPW + PQD + h * 64 + dkc]); kv[i] = bf2f(P[tok * NPW + PKD + h * 64 + dkc]); }
    u32x4 vst[4];
    if (ltid < 128) {
#pragma unroll
      for (int i = 0; i < 4; ++i) vst[i] = *(const u32x4*)(P + (rb + 4 * (ltid >> 3) + i) * NPW + PVD + h * 64 + (ltid & 7) * 8);
    }
    __syncthreads();
    float G[2][16], tot[2];
    gla_decay(p, layer, h, rb, aFB, SEG, tt, dkt, rr, hh, G, tot);
#pragma unroll
    for (int dir = 0; dir < 2; ++dir)
#pragma unroll
      for (int i = 0; i < 16; ++i) { const int t = tt * 32 + 16 * hh + i;
        QD[dir * 4608 + t * 72 + dkc] = f2bf(qv[i] * __expf(G[dir][i])); KI[dir * 4608 + t * 72 + dkc] = f2bf(kv[i] * __expf(-G[dir][i])); }
    if (ltid < 128) {
      const int tq2 = ltid >> 3, part = ltid & 7;
#pragma unroll
      for (int e = 0; e < 8; ++e) { const int wi = e >> 1; const bool hi = e & 1; unsigned s[4];
#pragma unroll
        for (int i = 0; i < 4; ++i) s[i] = hi ? (vst[i][wi] >> 16) : (vst[i][wi] & 0xffffu);
        u32x2 w; w.x = s[0] | (s[1] << 16); w.y = s[2] | (s[3] << 16);
        *(u32x2*)(VT + (part * 8 + e) * 72 + 4 * ((tq2 & ~3) | ((tq2 & 1) << 1) | ((tq2 & 2) >> 1))) = w; }
    }
    __syncthreads();
    f32x16 o = zero16();
#pragma unroll
    for (int dir = 0; dir < 2; ++dir) {
      bf16x8 qf[4];
#pragma unroll
      for (int ks = 0; ks < 4; ++ks) qf[ks] = ld_frag16(QD + dir * 4608 + (tt * 32 + rr) * 72 + ks * 16 + hh * 8);
#pragma unroll
      for (int st = 0; st < 2; ++st) {
        const bool use = dir ? (st >= tt) : (st <= tt);
        if (use) {
          f32x16 a = zero16();
#pragma unroll
          for (int ks = 0; ks < 4; ++ks) a = mfma32(ld_frag16(KI + dir * 4608 + (st * 32 + rr) * 72 + ks * 16 + hh * 8), qf[ks], a);
          const int t = tt * 32 + rr;
#pragma unroll
          for (int i = 0; i < 16; ++i) { const int s = st * 32 + (i & 3) + 8 * (i >> 2) + 4 * hh; const bool keep = dir ? (s >= t) : (s <= t); a[i] = keep ? a[i] : 0.f; }
#pragma unroll
          for (int sk = 0; sk < 2; ++sk) { const bf16_t* vp = VT + (dvt * 32 + rr) * 72 + st * 32 + 16 * sk + 8 * hh; o = mfma32(ld_frag16(vp), pack8(a, sk), o); }
        }
      }
#pragma unroll
      for (int ks = 0; ks < 4; ++ks) o = mfma32(stf[dir][ks], qf[ks], o);
    }
    float ss = 0.f;
#pragma unroll
    for (int i = 0; i < 16; ++i) ss += o[i] * o[i];
    ss += __shfl_xor(ss, 32);
    if (hh == 0) SS[dvt * 64 + tt * 32 + rr] = ss;
    __syncthreads();
    {
      const float tot = SS[tt * 32 + rr] + SS[64 + tt * 32 + rr];
      const float rstd = rsqrtf(tot * (1.f / 64.f) + 1e-6f);
      const size_t tok = rb + tt * 32 + rr;
#pragma unroll
      for (int g4 = 0; g4 < 4; ++g4) { const int dv = dvt * 32 + 8 * g4 + 4 * hh;
        const u32x2 gw = gwv[g4]; const f32x4 gg = *(const f32x4*)(gn + dv);
        u32x2 w; w.x = cvt_pk_bf16(o[4 * g4] * rstd * gg[0] * siluf(bflo(gw.x)), o[4 * g4 + 1] * rstd * gg[1] * siluf(bfhi(gw.x))); w.y = cvt_pk_bf16(o[4 * g4 + 2] * rstd * gg[2] * siluf(bflo(gw.y)), o[4 * g4 + 3] * rstd * gg[3] * siluf(bfhi(gw.y)));
        if (Y) *(u32x2*)(Y + tok * NPW + PVD + h * 64 + dv) = w; }
    }
  }
  __syncthreads();
}

#ifdef DBG
#define SEL4(k, a, b, c, d) ((k) == 0 ? (a) : (k) == 1 ? (b) : (k) == 2 ? (c) : (d))
constexpr size_t WS_DBG = WS_END;
__device__ __forceinline__ float bsum(float v, float* red, int tid) {
  __syncthreads(); red[tid] = v; __syncthreads();
  for (int s = 256; s > 0; s >>= 1) { if (tid < s) red[tid] += red[tid + s]; __syncthreads(); }
  const float r = red[0]; __syncthreads(); return r;
}
__device__ __forceinline__ float bmax(float v, float* red, int tid) {
  __syncthreads(); red[tid] = v; __syncthreads();
  for (int s = 256; s > 0; s >>= 1) { if (tid < s) red[tid] = fmaxf(red[tid], red[tid + s]); __syncthreads(); }
  const float r = red[0]; __syncthreads(); return r;
}
__device__ __forceinline__ void dbg_expect(const Params& p, const bf16_t* P, const float* aFB, float* dbg, unsigned char* lds) {
  const int tid = otid(); float* red = (float*)lds; float* Sm = (float*)(lds + 4096);
  const int i = obid(); if (i >= 28) return;
  const int cat = i >> 2, k = i & 3; float* ex = dbg + i * 64;
  const int layer = 0;
  if (cat == 0) {
    const int bs_ = SEL4(k, 0, 7, 19, 31), ss_ = SEL4(k, 0, 100, 255, 37), ds_ = SEL4(k, 0, 17, 63, 40);
    const int b = bs_, s = ss_, h = k, d = ds_; const size_t t = (size_t)b * 256 + s;
    float sc = -1e30f, vv = 0.f;
    if (tid < 256) { const size_t kt = (size_t)b * 256 + tid; float a = 0.f; for (int dd = 0; dd < 64; ++dd) a += bf2f(P[t * NPW + PQ + h * 64 + dd]) * bf2f(P[kt * NPW + PKA + h * 64 + dd]); sc = a; vv = bf2f(P[kt * NPW + PVA + h * 64 + d]); }
    const float m = bmax(sc, red, tid); const float pe = tid < 256 ? __expf(sc - m) : 0.f;
    const float l = bsum(pe, red, tid), o = bsum(pe * vv, red, tid);
    if (tid == 0) ex[0] = o / l * bf2f(P[t * NPW + PGA + h * 64 + d]);
  } else if (cat == 1) {
    const int rs4_ = SEL4(k, 0, 5, 63, 30), cs4_ = SEL4(k, 0, 63, 10, 33), ds_ = SEL4(k, 5, 60, 31, 0);
    const int b = k, r = rs4_, qc = cs4_, h = 3 - k, d = ds_; const size_t rb = (size_t)NCTXR + (size_t)b * 4096; const size_t t = rb + r * 64 + qc;
    const int rs = min(max(r - 4, 0), 56), cs = min(max(qc - 8, 0), 48);
    const int wi = tid >> 6, kc = tid & 63; const size_t kt = rb + (size_t)(rs + wi) * 64 + kc;
    float s1 = -1e30f, v1 = 0.f;
    if (kc >= cs && kc < cs + 16) { float a = 0.f; for (int dd = 0; dd < 64; ++dd) a += bf2f(P[t * NPW + PQ + h * 64 + dd]) * bf2f(P[kt * NPW + PKA + h * 64 + dd]);
      const int dr = rs + wi - r + 7, dc = min(max(kc - qc + 15, 0), 30); s1 = a + p.in[I_RPB][(((size_t)layer * 4 + h) * 15 + dr) * 31 + dc]; v1 = bf2f(P[kt * NPW + PVA + h * 64 + d]); }
    const size_t cb = ((((size_t)b * 4 + layer) * 4 + h) * 512 + tid) * 64;
    float s2 = 0.f; for (int dd = 0; dd < 64; ++dd) s2 += bf2f(P[t * NPW + PQ + h * 64 + dd]) * p.in[I_CK][cb + dd];
    const float v2 = p.in[I_CV][cb + d];
    const float m = bmax(fmaxf(s1, s2), red, tid); const float p1 = __expf(s1 - m), p2 = __expf(s2 - m);
    const float l = bsum(p1 + p2, red, tid), o = bsum(p1 * v1 + p2 * v2, red, tid);
    if (tid == 0) ex[0] = o / l * bf2f(P[t * NPW + PGA + h * 64 + d]);
  } else if (cat == 2 || cat == 3) {
    const bool den = cat == 3;
    const int bc_ = SEL4(k, 1, 30, 12, 5), kc4_ = SEL4(k, 0, 255, 77, 128), jc_ = SEL4(k, 0, 63, 21, 32), kd4_ = SEL4(k, 0, 4095, 1234, 2048), jd_ = SEL4(k, 1, 62, 33, 0);
    const int b = den ? k : bc_, kp = den ? kd4_ : kc4_, g = den ? 3 - k : k, j = den ? jd_ : jc_; const int S = den ? 4096 : 256;
    const size_t rb = den ? (size_t)NCTXR + (size_t)b * 4096 : (size_t)b * 256;
    float a = 0.f;
    for (int s = tid; s < S; s += NTHREADS) for (int c = 0; c < 64; ++c) { const float fr = (float)((kp * s) % S) / (float)S + (float)((j * c) & 63) / 64.f; a += bf2f(P[(rb + s) * NPW + PUC + g * 64 + c]) * cosf(6.283185307179586f * fr); }
    const float tot = bsum(a, red, tid);
    if (tid == 0) ex[0] = tot / sqrtf(64.f * S) * bf2f(P[(rb + kp) * NPW + PGC + g * 64 + j]);
    if (!den) { const int ka = kp & 3, s2 = (kp * 7 + 3) & 63; float tr = 0.f, ti = 0.f;
      if (tid < 256) { const int s1 = tid >> 6, c = tid & 63; const float ph = 6.283185307179586f * ((float)((ka * s1) & 3) * 0.25f + (float)((j * c) & 63) / 64.f + (float)((ka * s2) & 255) / 256.f);
        const float uu = bf2f(P[(rb + s1 * 64 + s2) * NPW + PUC + g * 64 + c]); tr = uu * cosf(ph); ti = -uu * sinf(ph); }
      const float sr = bsum(tr, red, tid), si = bsum(ti, red, tid);
      if (tid == 0) { ex[1] = sr / 128.f; ex[2] = si / 128.f; }
      for (int hyp = 1; hyp <= 6; ++hyp) { float hr = 0.f, hi2 = 0.f;
        if (tid < 256) { const int s1 = tid >> 6, c = tid & 63;
          float p1 = (float)((ka * s1) & 3) * 0.25f, p3 = (float)((ka * s2) & 255) / 256.f; const float p2 = (float)((j * c) & 63) / 64.f;
          if (hyp == 1) p3 = 0.f; if (hyp == 2 || hyp == 6) p1 = (float)((ka * s1) & 63) / 64.f; if (hyp == 3 || hyp == 6) p3 = (float)((ka * s2) & 4095) / 4096.f;
          const float ph = 6.283185307179586f * (p1 + p2 + p3); float uu = bf2f(P[(rb + s1 * 64 + s2) * NPW + PUC + g * 64 + c]);
          if (hyp == 4 && s1 > 0) uu = 0.f; if (hyp == 5) uu = 0.f;
          hr = uu * cosf(ph); hi2 = -uu * sinf(ph); }
        const float r1 = bsum(hr, red, tid), r2 = bsum(hi2, red, tid);
        if (tid == 0) { ex[2 * hyp + 1] = r1 / 128.f; ex[2 * hyp + 2] = r2 / 128.f; } } }
  } else if (cat == 4 || cat == 5) {
    const bool den = cat == 5;
    const int bc_ = SEL4(k, 2, 29, 15, 8), tc_ = SEL4(k, 0, 255, 64, 130), td_ = SEL4(k, 0, 4095, 63, 2100);
    const int b = den ? k : bc_, t = den ? td_ : tc_, h = den ? 3 - k : k; const int S = den ? 4096 : 256;
    const size_t rb = den ? (size_t)NCTXR + (size_t)b * 4096 : (size_t)b * 256;
    const int dk = tid >> 3, dv0 = (tid & 7) * 8;
    float osum = 0.f;
    for (int dir = 0; dir < 2; ++dir) {
      float St[8];
#pragma unroll
      for (int q = 0; q < 8; ++q) St[q] = den ? p.in[I_SG][(((((size_t)b * 4 + layer) * 2 + dir) * 4 + h) * 64 + dk) * 64 + dv0 + q] : 0.f;
      const float* up = p.in[dir ? I_UPB : I_UPF] + (size_t)layer * 16 * 256 + h * 64 + dk; const float bias = p.in[dir ? I_BB : I_BF][layer * 256 + h * 64 + dk];
      const int u0 = dir ? S - 1 : 0, du = dir ? -1 : 1; const int nsteps = dir ? S - t : t + 1;
      for (int st = 0; st < nsteps; ++st) { const int u = u0 + du * st; const size_t tok = rb + u;
        float z = bias; for (int q = 0; q < 16; ++q) z += aFB[tok * 32 + dir * 16 + q] * up[q * 256];
        const float a = __expf(logsigf(z) * (1.f / 16.f)); const float kk = bf2f(P[tok * NPW + PKD + h * 64 + dk]);
#pragma unroll
        for (int q = 0; q < 8; ++q) St[q] = a * St[q] + kk * bf2f(P[tok * NPW + PVD + h * 64 + dv0 + q]); }
      const float qq = bf2f(P[(rb + t) * NPW + PQD + h * 64 + dk]);
      __syncthreads();
#pragma unroll
      for (int q = 0; q < 8; ++q) Sm[dk * 64 + dv0 + q] = qq * St[q];
      __syncthreads();
      if (tid < 64) { float s = 0.f; for (int d2 = 0; d2 < 64; ++d2) s += Sm[d2 * 64 + tid]; osum += s; }
      __syncthreads();
    }
    float o = osum;
    const float ss = bsum(tid < 64 ? o * o : 0.f, red, tid);
    if (tid < 64) ex[tid] = o * rsqrtf(ss / 64.f + 1e-6f) * p.in[I_GN][layer * 64 + tid] * bf2f(P[(rb + t) * NPW + PGD + h * 64 + tid]);
  } else if (cat == 6) {
    const int rows_ = SEL4(k, 0, 255, 8192, 24575), chs_ = SEL4(k, 0, 100, 255, 7);
    const int row = rows_, ch = chs_; int s, S; if (row < NCTXR) { s = row & 255; S = 256; } else { s = (row - NCTXR) & 4095; S = 4096; }
    if (tid == 0) { float cv = 0.f; for (int d = 0; d < 3; ++d) { const int sd = s + d - 1; if (sd >= 0 && sd < S) { const size_t r2 = (size_t)row + d - 1; cv += bf2f(P[r2 * NPW + PCB + ch]) * bf2f(P[r2 * NPW + PHB + ch]) * p.in[I_CONV][layer * 768 + d * 256 + ch]; } }
      ex[0] = bf2f(P[(size_t)row * NPW + PBB + ch]) * cv * bf2f(P[(size_t)row * NPW + PGB + ch]); }
  }
}
__device__ __forceinline__ void dbg_compare(const bf16_t* P, float* dbg, const bf16_t* Zr, const bf16_t* Zi) {
  if (obid() != 0 || otid() != 0) return;
  int mask = 0, fine = 0, hypm = 0;
  for (int i = 0; i < 28; ++i) { const int cat = i >> 2, k = i & 3; const float* ex = dbg + i * 64; bool bad = false;
    if (cat == 0) { const int bs_ = SEL4(k, 0, 7, 19, 31), ss_ = SEL4(k, 0, 100, 255, 37), ds_ = SEL4(k, 0, 17, 63, 40); const size_t t = (size_t)bs_ * 256 + ss_;
      const float a = bf2f(P[t * NPW + PQ + k * 64 + ds_]); bad = !(fabsf(a - ex[0]) <= 0.01f + 0.03f * fabsf(ex[0])); }
    else if (cat == 1) { const int rs4_ = SEL4(k, 0, 5, 63, 30), cs4_ = SEL4(k, 0, 63, 10, 33), ds_ = SEL4(k, 5, 60, 31, 0); const size_t t = (size_t)NCTXR + (size_t)k * 4096 + rs4_ * 64 + cs4_;
      const float a = bf2f(P[t * NPW + PQ + (3 - k) * 64 + ds_]); bad = !(fabsf(a - ex[0]) <= 0.01f + 0.03f * fabsf(ex[0])); }
    else if (cat == 2) { const int bc_ = SEL4(k, 1, 30, 12, 5), kc4_ = SEL4(k, 0, 255, 77, 128), jc_ = SEL4(k, 0, 63, 21, 32); const size_t t = (size_t)bc_ * 256 + kc4_;
      const float a = bf2f(P[t * NPW + PUC + k * 64 + jc_]); bad = !(fabsf(a - ex[0]) <= 0.01f + 0.03f * fabsf(ex[0]));
      if (bad) fine |= (1 << k);
      const int ka = kc4_ & 3, s2 = (kc4_ * 7 + 3) & 63; const size_t zo = (((size_t)(bc_ * 4 + k) * 4 + ka) * 64 + jc_) * 64 + s2;
      const float zr = bf2f(Zr[zo]), zi = bf2f(Zi[zo]);
      if (k == 1) { for (int hyp = 1; hyp <= 6; ++hyp) if ((fabsf(zr - ex[2 * hyp + 1]) <= 0.01f + 0.03f * fabsf(ex[2 * hyp + 1])) && (fabsf(zi - ex[2 * hyp + 2]) <= 0.01f + 0.03f * fabsf(ex[2 * hyp + 2]))) hypm |= (1 << (hyp - 1)); } }
    else if (cat == 3) { const int kd4_ = SEL4(k, 0, 4095, 1234, 2048), jd_ = SEL4(k, 1, 62, 33, 0); const size_t t = (size_t)NCTXR + (size_t)k * 4096 + kd4_;
      const float a = bf2f(P[t * NPW + PUC + (3 - k) * 64 + jd_]); bad = !(fabsf(a - ex[0]) <= 0.01f + 0.03f * fabsf(ex[0])); }
    else if (cat == 4 || cat == 5) { const bool den = cat == 5; const int bc_ = SEL4(k, 2, 29, 15, 8), tc_ = SEL4(k, 0, 255, 64, 130), td_ = SEL4(k, 0, 4095, 63, 2100);
      const size_t t = den ? (size_t)NCTXR + (size_t)k * 4096 + td_ : (size_t)bc_ * 256 + tc_; const int h = den ? 3 - k : k;
      for (int d = 0; d < 64; ++d) { const float a = bf2f(P[t * NPW + PVD + h * 64 + d]); if (!(fabsf(a - ex[d]) <= 0.01f + 0.03f * fabsf(ex[d]))) bad = true; } }
    else { const int rows_ = SEL4(k, 0, 255, 8192, 24575), chs_ = SEL4(k, 0, 100, 255, 7);
      const float a = bf2f(P[(size_t)rows_ * NPW + PBB + chs_]); bad = !(fabsf(a - ex[0]) <= 0.01f + 0.03f * fabsf(ex[0])); }
    if (bad) mask |= (1 << cat);
  }
  dbg[32 * 64] = (float)((mask & 63) ? (mask & 63) : (mask >> 6) * 64); (void)fine; (void)hypm;
}
#endif
__global__ void __launch_bounds__(NTHREADS) fwd_megakernel(Params p) {
  const int tidx_ = otid(), bidx_ = obid(), gdim_ = ogdim(); (void)tidx_; (void)bidx_; (void)gdim_;
  extern __shared__ __attribute__((aligned(16))) unsigned char lds[];
  cg::grid_group grid = cg::this_grid();
  volatile LAS unsigned* bst = (volatile LAS unsigned*)((LAS unsigned char*)lds + (LDS_BYTES - 16));
  if (threadIdx.x == 0) { bst[0] = 0u; bst[1] = 0u; }
  __syncthreads();
  const XcdBarrier xb = xcd_barrier_post((unsigned*)(p.ws + WS_BAR), bst);
  unsigned char* ws = p.ws;
  bf16_t* P = (bf16_t*)(ws + WS_P); bf16_t* hN = (bf16_t*)(ws + WS_R);
  bf16_t* Zr = (bf16_t*)(ws + WS_R); bf16_t* Zi = (bf16_t*)(ws + WS_R + R_ZI); bf16_t* ST = (bf16_t*)(ws + WS_R + R_ST);
  bf16_t* WinT0 = (bf16_t*)(ws + WS_WIN); bf16_t* WaT0 = (bf16_t*)(ws + WS_WA); bf16_t* WoutT0 = (bf16_t*)(ws + WS_WOUT);
  float* mod = (float*)(ws + WS_MOD); float* aFB = (float*)(ws + WS_AFB); float* DEC = (float*)(ws + WS_DEC);
  LAS unsigned char* ldsl = (LAS unsigned char*)lds;
  bf16_t* DRY = nullptr; asm volatile("" : "+s"(DRY)); (void)DRY;

  phase_mod(p, (float*)(ws + WS_P), lds);
  phase_wconv(p, 0, WinT0, WaT0, WoutT0, lds, 0, gdim_);
  phase_cachecvt(p, (bf16_t*)(ws + WS_CKB), (bf16_t*)(ws + WS_CVB));
  if (p.ws == nullptr) grid.sync();
  xcd_barrier(xb);
  phase_mod_reduce(p, (const float*)(ws + WS_P), mod);
  xcd_barrier(xb);
  for (int layer = 0; layer < 4; ++layer) {
    const float* mod_l = mod + (size_t)layer * 5 * 3072;
    const int par = layer & 1;
    bf16_t* WinT = WinT0 + (size_t)par * NPW * DM; bf16_t* WaT = WaT0 + (size_t)par * 32 * DM; bf16_t* WoutT = WoutT0 + (size_t)par * DM * DM;
#if PROBE == 6
    phase_norm(p, layer, mod_l, hN, WinT, WaT, WoutT, lds);
#endif
    phase_norm(p, layer, mod_l, hN, WinT, WaT, WoutT, lds);
    xcd_barrier(xb);
    {
      pg8::Gemm g{hN, WinT, MROWS, NPW, DM, DM};
      pg8::StaticOrder S; S.init(MROWS, NPW, gdim_, bidx_);
      EpiIn E{P, p.in[I_QG] + layer * 64, p.in[I_KG] + layer * 64, p.out + OFF_CK, p.out + OFF_CV, layer};
#if PROBE == 5
      pg8::gemm_phase<EpiIn>(ldsl, g, S, E);
      phase_afb(hN, WaT, aFB);
#endif
      pg8::gemm_phase<EpiIn>(ldsl, g, S, E);
      phase_afb(hN, WaT, aFB);
    }
    xcd_barrier(xb);
#ifdef DBG
    if (layer == 0) { dbg_expect(p, P, aFB, (float*)(ws + WS_DBG), lds); __syncthreads(); }
#endif
#if PROBE == 1
    attn_den(p, layer, P, DRY, lds);
#endif
    attn_den(p, layer, P, P, lds);
#if PROBE == 8
    attn_ctx(P, DRY, lds); conv_mix(p, layer, P, DRY);
#endif
    attn_ctx(P, P, lds);
    conv_mix(p, layer, P, P);
#if PROBE == 3
    fourier1(P, Zr, Zi, lds);
#endif
    fourier1(P, Zr, Zi, lds);
#if PROBE == 4
    gla1(p, layer, P, aFB, ST, DEC, lds);
#endif
    gla1(p, layer, P, aFB, ST, DEC, lds);
    xcd_barrier(xb);
#if PROBE == 10
    fourier2(P, Zr, Zi, lds);
#endif
    fourier2(P, Zr, Zi, lds);
    gla2(p, layer, ST, DEC);
    xcd_barrier(xb);
#if PROBE == 2
    gla3(p, layer, P, DRY, aFB, ST, lds);
#endif
    gla3(p, layer, P, P, aFB, ST, lds);
    xcd_barrier(xb);
#if PROBE == 7
    for (int i = 0; i < 6; ++i) xcd_barrier(xb);
#endif
#ifdef DBG
    if (layer == 0) dbg_compare(P, (float*)(ws + WS_DBG), Zr, Zi);
#endif
    {
      pg8::Gemm g{P, WoutT, MROWS, DM, DM, NPW};
      pg8::StaticOrder S; S.init(MROWS, DM, gdim_, bidx_);
#if PROBE == 9
      { EpiOut E0{layer == 0 ? p.in[I_XP] : nullptr, p.in[I_XS], p.out, mod_l, (float*)DRY}; pg8::gemm_phase<EpiOut>(ldsl, g, S, E0); }
#endif
      EpiOut E{layer == 0 ? p.in[I_XP] : nullptr, p.in[I_XS], p.out, mod_l, p.out};
      pg8::gemm_phase<EpiOut>(ldsl, g, S, E);
      if (layer < 3) { const int np = par ^ 1; const int b0 = (gdim_ == 256) ? 128 : 0;
        phase_wconv(p, layer + 1, WinT0 + (size_t)np * NPW * DM, WaT0 + (size_t)np * 32 * DM, WoutT0 + (size_t)np * DM * DM, lds, b0, gdim_ - b0); }
    }
    xcd_barrier(xb);
  }
#ifdef DBG
  if (obid() == 0 && otid() == 0) p.out[0] += 10000.f * ((float*)(ws + WS_DBG))[32 * 64];
#endif
}

extern "C" void kernel_launch(void* const* d_in, const int* in_sizes, int n_in, void* d_out, int out_size,
                              void* d_ws, size_t ws_size, hipStream_t stream) {
  static int grid_blocks = 0;
  if (!grid_blocks) {
    int dev = 0, cus = 0;
    (void)hipGetDevice(&dev);
    (void)hipDeviceGetAttribute(&cus, hipDeviceAttributeMultiprocessorCount, dev);
    (void)hipFuncSetAttribute((const void*)fwd_megakernel, hipFuncAttributeMaxDynamicSharedMemorySize, LDS_BYTES);
    grid_blocks = cus > 0 ? cus : 256;
    if (ws_size < WS_END) fprintf(stderr, "workspace too small: %zu < %zu\n", ws_size, (size_t)WS_END);
  }
  (void)hipMemsetAsync((unsigned char*)d_ws + WS_BAR, 0, (size_t)XCD_BAR_WORDS * 4, stream);
  Params p{};
  for (int i = 0; i < 21; ++i) p.in[i] = (const float*)d_in[i];
  p.out = (float*)d_out;
  p.ws = (unsigned char*)d_ws;
  void* args[] = {&p};
  hipError_t e = hipLaunchCooperativeKernel((void*)fwd_megakernel, dim3(grid_blocks), dim3(NTHREADS), args, LDS_BYTES, stream);
  if (e != hipSuccess) fprintf(stderr, "cooperative launch failed: %s (grid %d)\n", hipGetErrorString(e), grid_blocks);
}
```
